# Optimizing an MI355X kernel written in HIP

```python
import jax, jax.numpy as jnp
from jax import lax
import numpy as np

D_MODEL = 2048
BATCH = 2
SEQ = 4096
DEPTH = 2

GRID_W = 64
CTX_LEN = 256
MIX_WIDTH = D_MODEL
HEAD_DIM = 128
N_DIR = 2
GLA_WIDTH = MIX_WIDTH // 4
GLA_HEADS = GLA_WIDTH // HEAD_DIM
GLA_DV = HEAD_DIM
GLA_DK = HEAD_DIM // 2
GLA_RANK = 16
GLA_TAU = 16.0
HG_WIDTH = MIX_WIDTH // 4
HG_HEADS = HG_WIDTH // HEAD_DIM
HG_EXPAND = HEAD_DIM
HG_DV = HEAD_DIM
NA_WIDTH = MIX_WIDTH // 2
NA_HEADS = NA_WIDTH // HEAD_DIM
NA_DH = HEAD_DIM
WIN_ROWS = 8
WIN_COLS = 16
D_FF = 4 * D_MODEL
CHUNK = 64
ROPE_BASE = 10000.0
EPS = 1e-6
IN_SIZES = (GLA_HEADS * GLA_DK, GLA_HEADS * GLA_DK, GLA_WIDTH, GLA_WIDTH, N_DIR * GLA_RANK,
            HG_WIDTH, N_DIR * HG_WIDTH, HG_WIDTH, HG_WIDTH,
            NA_WIDTH, NA_WIDTH, NA_WIDTH)
IN_COLS = sum(IN_SIZES)

kernel_name = "hybrid_gla_hgrn2_natten_dit_block"


def rmsnorm(x, g):
    xf = x.astype(jnp.float32)
    y = xf * lax.rsqrt(jnp.mean(xf * xf, axis=-1, keepdims=True) + EPS)
    return (y * g.astype(jnp.float32)).astype(x.dtype)


def split_cols(p):
    return jnp.split(p, np.cumsum(IN_SIZES)[:-1].tolist(), axis=-1)


def to_heads(t, n_heads):
    b, t_len, _ = t.shape
    return t.reshape(b, t_len, n_heads, -1).transpose(0, 2, 1, 3)


def from_heads(t):
    b, h, t_len, d = t.shape
    return t.transpose(0, 2, 1, 3).reshape(b, t_len, h * d)


def axial_rope(x, row_pos, col_pos):
    half = x.shape[-1] // 2
    quarter = half // 2
    inv_freq = ROPE_BASE ** (-jnp.arange(quarter, dtype=jnp.float32) / quarter)
    xf = x.astype(jnp.float32)

    def rotate(xa, pos):
        ang = pos.astype(jnp.float32)[:, None] * inv_freq
        cos, sin = jnp.cos(ang), jnp.sin(ang)
        x1, x2 = xa[..., :quarter], xa[..., quarter:]
        return jnp.concatenate([x1 * cos - x2 * sin, x1 * sin + x2 * cos], axis=-1)

    return jnp.concatenate([rotate(xf[..., :half], row_pos), rotate(xf[..., half:], col_pos)], axis=-1).astype(x.dtype)


def chunk_gated_scan(q, k, v, log_a, s0):
    b, h, t_len, dk = q.shape
    dv = v.shape[-1]
    n = t_len // CHUNK

    def chunks(t):
        return jnp.moveaxis(t.astype(jnp.float32).reshape(b, h, n, CHUNK, t.shape[-1]), 2, 0)

    lower = jnp.tril(jnp.ones((CHUNK, CHUNK), dtype=bool))[:, :, None]

    def step(s, blk):
        qb, kb, vb, gb = blk
        cum = jnp.cumsum(gb, axis=2)
        rel = jnp.where(lower, cum[:, :, :, None, :] - cum[:, :, None, :, :], -jnp.inf)
        att = jnp.einsum('bhid,bhjd,bhijd->bhij', qb, kb, jnp.exp(rel))
        o = jnp.einsum('bhij,bhjv->bhiv', att, vb) + jnp.einsum('bhid,bhdv->bhiv', qb * jnp.exp(cum), s)
        cum_end = cum[:, :, -1:, :]
        s_new = jnp.exp(cum_end[:, :, 0, :, None]) * s + jnp.einsum('bhjd,bhjv->bhdv', kb * jnp.exp(cum_end - cum), vb)
        return s_new, o

    s_fin, o = lax.scan(step, s0, (chunks(q), chunks(k), chunks(v), chunks(log_a)))
    return jnp.moveaxis(o, 0, 2).reshape(b, h, t_len, dv), s_fin


def prefix_scan(ctx_in, lat_in, reverse):
    if reverse:
        ctx_in = tuple(t[:, :, ::-1] for t in ctx_in)
        lat_in = tuple(t[:, :, ::-1] for t in lat_in)
    b, h, _, dk = ctx_in[0].shape
    dv = ctx_in[2].shape[-1]
    s0 = jnp.zeros((b, h, dk, dv), jnp.float32)
    o_ctx, s_ctx = chunk_gated_scan(*ctx_in, s0)
    o_lat, _ = chunk_gated_scan(*lat_in, s_ctx)
    if reverse:
        o_ctx, o_lat = o_ctx[:, :, ::-1], o_lat[:, :, ::-1]
    return o_ctx, o_lat


def gated_readout(o, gate, norm_g):
    return (from_heads(rmsnorm(o, norm_g)) * jax.nn.silu(gate.astype(jnp.float32))).astype(gate.dtype)


def gla_mixer(p_ctx, p_lat, w_a2, b_a, norm_g, row_pos, col_pos, with_ctx_out):
    def prep(p, rotate):
        q, k, v, r, a_low = p
        q = to_heads(q, GLA_HEADS) * GLA_DK ** -0.5
        k = to_heads(k, GLA_HEADS)
        if rotate:
            q, k = axial_rope(q, row_pos, col_pos), axial_rope(k, row_pos, col_pos)
        v = to_heads(v, GLA_HEADS)
        log_a = tuple(
            to_heads(jax.nn.log_sigmoid((a_low[..., d * GLA_RANK:(d + 1) * GLA_RANK] @ w_a2[d] + b_a[d]).astype(jnp.float32)) / GLA_TAU, GLA_HEADS)
            for d in range(N_DIR))
        return q, k, v, r, log_a

    qc, kc, vc, rc, gc = prep(p_ctx, False)
    ql, kl, vl, rl, gl = prep(p_lat, True)
    oc_f, ol_f = prefix_scan((qc, kc, vc, gc[0]), (ql, kl, vl, gl[0]), reverse=False)
    oc_b, ol_b = prefix_scan((qc, kc, vc, gc[1]), (ql, kl, vl, gl[1]), reverse=True)
    y_lat = gated_readout(ol_f + ol_b, rl, norm_g)
    y_ctx = gated_readout(oc_f + oc_b, rc, norm_g) if with_ctx_out else None
    return y_lat, y_ctx


def hgrn2_mixer(p_ctx, p_lat, lower_bound, norm_g, with_ctx_out):
    def prep(p):
        q, f2, i, g = p
        q = jax.nn.silu(to_heads(q, HG_HEADS))
        v = to_heads(i, HG_HEADS)
        ks, log_f = [], []
        for d in range(N_DIR):
            logit = to_heads(f2[..., d * HG_WIDTH:(d + 1) * HG_WIDTH], HG_HEADS).astype(jnp.float32)
            lb = lower_bound[d].reshape(HG_HEADS, 1, HG_EXPAND)
            forget = lb + (1.0 - lb) * jax.nn.sigmoid(logit)
            log_f.append(jnp.log(forget))
            ks.append((1.0 - lb) * jax.nn.sigmoid(-logit))
        return q, v, g, ks, log_f

    qc, vc, gtc, kc, fc = prep(p_ctx)
    ql, vl, gtl, kl, fl = prep(p_lat)
    oc_f, ol_f = prefix_scan((qc, kc[0], vc, fc[0]), (ql, kl[0], vl, fl[0]), reverse=False)
    oc_b, ol_b = prefix_scan((qc, kc[1], vc, fc[1]), (ql, kl[1], vl, fl[1]), reverse=True)
    y_lat = gated_readout(ol_f + ol_b, gtl, norm_g)
    y_ctx = gated_readout(oc_f + oc_b, gtc, norm_g) if with_ctx_out else None
    return y_lat, y_ctx


def neighbourhood_attention(q, k, v, k_ctx, v_ctx, rpb):
    b, h, t_len, dh = q.shape
    rows = t_len // GRID_W
    kr = min(WIN_ROWS, rows)
    kc = WIN_COLS
    qg, kg, vg = (t.reshape(b, h, rows, GRID_W, dh) for t in (q, k, v))
    row_start = jnp.clip(jnp.arange(rows) - kr // 2, 0, rows - kr)
    col_start = jnp.clip(jnp.arange(GRID_W) - kc // 2, 0, GRID_W - kc)
    col_idx = col_start[:, None] + jnp.arange(kc)
    dc = col_idx - jnp.arange(GRID_W)[:, None] + WIN_COLS - 1
    scale = dh ** -0.5
    n_win = kr * kc

    def row_block(args):
        q_r, r0, r = args
        k_win = lax.dynamic_slice_in_dim(kg, r0, kr, axis=2)[:, :, :, col_idx]
        v_win = lax.dynamic_slice_in_dim(vg, r0, kr, axis=2)[:, :, :, col_idx]
        dr = r0 + jnp.arange(kr) - r + WIN_ROWS - 1
        bias = rpb[:, dr[None, :, None], dc[:, None, :]]
        s_win = jnp.einsum('bhqd,bhrqcd->bhqrc', q_r, k_win).astype(jnp.float32) * scale + bias.astype(jnp.float32)
        s_ctx = jnp.einsum('bhqd,bhkd->bhqk', q_r, k_ctx).astype(jnp.float32) * scale
        s = jnp.concatenate([s_win.reshape(b, h, GRID_W, n_win), s_ctx], axis=-1)
        p = jax.nn.softmax(s, axis=-1).astype(v.dtype)
        p_win = p[..., :n_win].reshape(b, h, GRID_W, kr, kc)
        return (jnp.einsum('bhqrc,bhrqcd->bhqd', p_win, v_win)
                + jnp.einsum('bhqk,bhkd->bhqd', p[..., n_win:], v_ctx))

    o = lax.map(row_block, (jnp.moveaxis(qg, 2, 0), row_start, jnp.arange(rows)))
    return jnp.moveaxis(o, 0, 2).reshape(b, h, t_len, dh)


def context_attention(q, k, v):
    s = jnp.einsum('bhqd,bhkd->bhqk', q, k).astype(jnp.float32) * q.shape[-1] ** -0.5
    return jnp.einsum('bhqk,bhkd->bhqd', jax.nn.softmax(s, axis=-1).astype(v.dtype), v)


def na_mixer(p_ctx, p_lat, q_norm, k_norm, rpb, with_ctx_out):
    def prep(p):
        q, k, v = p
        return (rmsnorm(to_heads(q, NA_HEADS), q_norm), rmsnorm(to_heads(k, NA_HEADS), k_norm), to_heads(v, NA_HEADS))

    qc, kc, vc = prep(p_ctx)
    ql, kl, vl = prep(p_lat)
    y_lat = from_heads(neighbourhood_attention(ql, kl, vl, kc, vc, rpb))
    y_ctx = from_heads(context_attention(qc, kc, vc)) if with_ctx_out else None
    return y_lat, y_ctx


def sqrelu_mlp(h, w1, w2):
    return jnp.square(jax.nn.relu(h @ w1)) @ w2


def setup_inputs(seed: int = 0) -> dict:
    key = jax.random.key(seed)
    ks = jax.random.split(key, 20)

    def nrm(k, shape, s):
        return jax.random.normal(k, shape, jnp.float32) * s

    return {
        "x": nrm(ks[0], (BATCH, SEQ, D_MODEL), 1.0),
        "c": nrm(ks[1], (BATCH, D_MODEL), 1.0),
        "ctx": nrm(ks[2], (BATCH, CTX_LEN, D_MODEL), 1.0),
        "c_ctx": nrm(ks[3], (D_MODEL,), 1.0),
        "w_mod": nrm(ks[4], (DEPTH, D_MODEL, 6 * D_MODEL), 0.5 * D_MODEL ** -0.5),
        "b_mod": nrm(ks[5], (DEPTH, 6 * D_MODEL), 0.02),
        "attn_norm": 1.0 + nrm(ks[6], (DEPTH, D_MODEL), 0.02),
        "w_in": nrm(ks[7], (DEPTH, D_MODEL, IN_COLS), D_MODEL ** -0.5),
        "gla_w_a2": nrm(ks[8], (DEPTH, N_DIR, GLA_RANK, GLA_HEADS * GLA_DK), GLA_RANK ** -0.5),
        "gla_b_a": nrm(ks[9], (DEPTH, N_DIR, GLA_HEADS * GLA_DK), 0.1),
        "gla_norm": 1.0 + nrm(ks[10], (DEPTH, GLA_DV), 0.02),
        "hg_lower_bounds": nrm(ks[11], (DEPTH, N_DIR, HG_WIDTH), 0.1),
        "hg_norm": 1.0 + nrm(ks[12], (DEPTH, HG_DV), 0.02),
        "na_q_norm": 1.0 + nrm(ks[13], (DEPTH, NA_DH), 0.02),
        "na_k_norm": 1.0 + nrm(ks[14], (DEPTH, NA_DH), 0.02),
        "na_rpb": nrm(ks[15], (DEPTH, NA_HEADS, 2 * WIN_ROWS - 1, 2 * WIN_COLS - 1), 0.1),
        "w_out": nrm(ks[16], (DEPTH, MIX_WIDTH, D_MODEL), MIX_WIDTH ** -0.5),
        "mlp_norm": 1.0 + nrm(ks[17], (DEPTH, D_MODEL), 0.02),
        "w_mlp1": nrm(ks[18], (DEPTH, D_MODEL, D_FF), D_MODEL ** -0.5),
        "w_mlp2": nrm(ks[19], (DEPTH, D_FF, D_MODEL), D_FF ** -0.5),
    }


def reference(x, c, ctx, c_ctx, w_mod, b_mod, attn_norm, w_in, gla_w_a2, gla_b_a, gla_norm,
              hg_lower_bounds, hg_norm, na_q_norm, na_k_norm, na_rpb, w_out, mlp_norm, w_mlp1, w_mlp2):
    t_len = x.shape[1]
    pos = jnp.arange(t_len)
    row_pos, col_pos = pos // GRID_W, pos % GRID_W
    lb_p = jax.nn.softmax(hg_lower_bounds.astype(jnp.float32), axis=0)
    lower_bounds = jnp.cumsum(lb_p, axis=0) - lb_p[0]

    for l in range(DEPTH):
        with_ctx_out = l < DEPTH - 1
        mod_lat = (jax.nn.silu(c) @ w_mod[l] + b_mod[l])[:, None, :]
        mod_ctx = jax.nn.silu(c_ctx) @ w_mod[l] + b_mod[l]
        sh_a, sc_a, g_a, sh_m, sc_m, g_m = jnp.split(mod_lat, 6, axis=-1)
        csh_a, csc_a, cg_a, csh_m, csc_m, cg_m = jnp.split(mod_ctx, 6, axis=-1)

        h_lat = rmsnorm(x, attn_norm[l]) * (1.0 + sc_a) + sh_a
        h_ctx = rmsnorm(ctx, attn_norm[l]) * (1.0 + csc_a) + csh_a
        p_lat = split_cols(h_lat @ w_in[l])
        p_ctx = split_cols(h_ctx @ w_in[l])

        ya_lat, ya_ctx = gla_mixer(p_ctx[0:5], p_lat[0:5], gla_w_a2[l], gla_b_a[l], gla_norm[l], row_pos, col_pos, with_ctx_out)
        yb_lat, yb_ctx = hgrn2_mixer(p_ctx[5:9], p_lat[5:9], lower_bounds[l], hg_norm[l], with_ctx_out)
        yc_lat, yc_ctx = na_mixer(p_ctx[9:12], p_lat[9:12], na_q_norm[l], na_k_norm[l], na_rpb[l], with_ctx_out)

        y_lat = jnp.concatenate([ya_lat, yb_lat, yc_lat], axis=-1)
        x = x + g_a * (y_lat @ w_out[l])
        x = x + g_m * sqrelu_mlp(rmsnorm(x, mlp_norm[l]) * (1.0 + sc_m) + sh_m, w_mlp1[l], w_mlp2[l])
        if with_ctx_out:
            y_ctx = jnp.concatenate([ya_ctx, yb_ctx, yc_ctx], axis=-1)
            ctx = ctx + cg_a * (y_ctx @ w_out[l])
            ctx = ctx + cg_m * sqrelu_mlp(rmsnorm(ctx, mlp_norm[l]) * (1.0 + csc_m) + csh_m, w_mlp1[l], w_mlp2[l])
    return x
```

```cpp
#include <hip/hip_runtime.h>
#include <hip/hip_cooperative_groups.h>
#include <cstdio>
#include <cstdint>
namespace cg = cooperative_groups;
#ifndef MK_ONE_LAUNCH
#define MK_ONE_LAUNCH 0
#endif
namespace pg8 {
#define PG8_LAS __attribute__((address_space(3)))
typedef unsigned short bf16_t;
typedef short bf16x8 __attribute__((ext_vector_type(8)));
typedef float f32x4 __attribute__((ext_vector_type(4)));
typedef unsigned u32x4 __attribute__((ext_vector_type(4)));
constexpr int BM = 256, BK = 64, HALF = 128, HTB = HALF * BK * 2  , STAGE_BYTES = 8 * HTB, NXCD = 8, WGM = 8;

__host__ __device__ __forceinline__ int lds_byte(int r, int c) { const int st = (r >> 4) * 2 + (c >> 5), rr = r & 15, cc = c & 31, ob = rr * 64 + cc * 2; return st * 1024 + (ob ^ (((ob >> 9) & 1) << 5)); }
__host__ __device__ __forceinline__ void stage_rc(int b, int& R, int& C) { const int st = b / 1024, sb = b % 1024, swz = sb ^ (((sb >> 9) & 1) << 5); R = (st >> 1) * 16 + swz / 64; C = (st & 1) * 32 + (swz % 64) / 2; }
__host__ __device__ __forceinline__ int perm32(int rho) { const int n = rho >> 4, i = rho & 15; return 8 * (i >> 2) + 4 * n + (i & 3); }

struct Unit { int pm, pn; };
struct Gemm { const bf16_t* A; const bf16_t* Bt; int M, N, K; };

struct StaticOrder {
    int nM, nN, nwg, G, c;
    __host__ __device__ void init(int M, int N, int G_, int c_) { nM = M / BM; nN = N / BM; nwg = nM * nN; G = G_; c = c_; }
    __host__ __device__ bool next(int i, Unit& u) const {
        const long L = (long)i * G + c; if (L >= nwg) return false;
        int wgid = (int)L; { const int q = nwg / NXCD, r = nwg % NXCD, xcd = wgid % NXCD, off = wgid / NXCD; wgid = (xcd < r ? xcd * (q + 1) : r * (q + 1) + (xcd - r) * q) + off; }
        const int nig = WGM * nN, gid = wgid / nig, fm = gid * WGM, gsz = (nM - fm) < WGM ? (nM - fm) : WGM;
        u.pm = fm + ((wgid % nig) % gsz); u.pn = (wgid % nig) / gsz; return true;
    }
    __device__ __forceinline__ void a_ready(const Unit&) const {}
    __device__ __forceinline__ void done(const Unit&) const {}
};

__device__ __forceinline__ unsigned cvt_pk_bf16(float lo, float hi) { unsigned r; asm volatile("v_cvt_pk_bf16_f32 %0, %1, %2" : "=v"(r) : "v"(lo), "v"(hi)); return r; }
template <int ACT  > struct EpiStoreBf16 {
    static constexpr bool PERM = true, AFTER_DRAIN = false;
    bf16_t* O; int ldc;
    __device__ __forceinline__ void operator()(const f32x4 (&acc)[2][2][4][2], const Unit& u, int wr, int wc, int fr, int fq) const {
        const int row0 = u.pm * BM + wr * 64 + fr; const int col0 = u.pn * BM + wc * 32 + 8 * fq;
#pragma unroll
        for (int ai = 0; ai < 2; ++ai)
#pragma unroll
            for (int m = 0; m < 4; ++m) { bf16_t* rowp = O + (size_t)(row0 + ai * HALF + m * 16) * ldc + col0;
#pragma unroll
                for (int bj = 0; bj < 2; ++bj) { f32x4 v0 = acc[ai][bj][m][0], v1 = acc[ai][bj][m][1];
                    if (ACT == 2) {
#pragma unroll
                        for (int e = 0; e < 4; ++e) { float a0 = v0[e] > 0.f ? v0[e] : 0.f, a1 = v1[e] > 0.f ? v1[e] : 0.f; v0[e] = a0 * a0; v1[e] = a1 * a1; } }
                    u32x4 w; w.x = cvt_pk_bf16(v0[0], v0[1]); w.y = cvt_pk_bf16(v0[2], v0[3]); w.z = cvt_pk_bf16(v1[0], v1[1]); w.w = cvt_pk_bf16(v1[2], v1[3]);
                    *(u32x4*)(rowp + bj * HALF) = w; } }
    }
};
struct EpiResGate {
    static constexpr bool PERM = true, AFTER_DRAIN = false;
    const float* res_lat; const float* res_ctx; float* out_lat; float* out_ctx; const float* gate;
    __device__ __forceinline__ void operator()(const f32x4 (&acc)[2][2][4][2], const Unit& u, int wr, int wc, int fr, int fq) const {
        const int rt = u.pm * BM; const float* rb; float* ob; const float* g;
        if (rt < 8192) { rb = res_lat + (size_t)rt * 2048; ob = out_lat + (size_t)rt * 2048; g = gate + (rt >> 12) * 12288; }
        else { rb = res_ctx + (size_t)(rt - 8192) * 2048; ob = out_ctx + (size_t)(rt - 8192) * 2048; g = gate + 2 * 12288; }
        const int lr0 = wr * 64 + fr, col0 = u.pn * BM + wc * 32 + 8 * fq;
#pragma unroll
        for (int bj = 0; bj < 2; ++bj)
#pragma unroll
            for (int n = 0; n < 2; ++n) { const f32x4 gv = *(const f32x4*)(g + col0 + bj * HALF + 4 * n);
#pragma unroll
                for (int ai = 0; ai < 2; ++ai)
#pragma unroll
                    for (int m = 0; m < 4; ++m) { const size_t ro = (size_t)(lr0 + ai * HALF + m * 16) * 2048 + col0 + bj * HALF + 4 * n;
                        const f32x4 r = *(const f32x4*)(rb + ro);
                        *(f32x4*)(ob + ro) = r + gv * acc[ai][bj][m][n]; } }
    }
};
template <class Epi, class Sched, bool ALIGN_EPI = false, bool SP2 = false>
__device__ __forceinline__ void gemm_phase(PG8_LAS unsigned char* lds, const Gemm g, const Sched& S, const Epi& E) {
    const int tid = threadIdx.x, wid = __builtin_amdgcn_readfirstlane(tid >> 6), lane = tid & 63, wr = wid >> 2, wc = wid & 3, fr = lane & 15, fq = lane >> 4;
    const int K = g.K, nt = K / BK;
    unsigned voffA[2], voffB[2];
#pragma unroll
    for (int i = 0; i < 2; ++i) { int R, C; stage_rc(tid * 16 + i * 8192, R, C); const int Rb = Epi::PERM ? ((R & ~31) + perm32(R & 31)) : R;
        voffA[i] = (unsigned)(R * K + C) * 2u; voffB[i] = (unsigned)(Rb * K + C) * 2u; }
    const size_t kstep = (size_t)(BK * 2);
    const size_t hstep = (size_t)HALF * K * 2;
    const size_t tstep = 2 * hstep;
    const unsigned ldsw = (unsigned)wid * 1024u;
    const int aoff = lds_byte(wr * 64 + fr, fq * 8), boff = lds_byte(wc * 32 + fr, fq * 8);
#define PG8_SA(b, h) (((b) * 2 + (h)) * HTB)
#define PG8_SB(b, h) ((4 + (b) * 2 + (h)) * HTB)
#define PG8_STAGE(bufoff, gbase, voff) do { _Pragma("unroll") for (int _i = 0; _i < 2; ++_i) \
        __builtin_amdgcn_global_load_lds((const unsigned*)((const char*)(gbase) + (voff)[_i]), (PG8_LAS unsigned*)(lds + (bufoff) + ldsw + _i * 8192), 16, 0, 0); } while (0)
#define PG8_LDA(dst, b, h) do { _Pragma("unroll") for (int m = 0; m < 4; ++m) _Pragma("unroll") for (int k = 0; k < 2; ++k) dst[m][k] = *(const PG8_LAS bf16x8*)(lds + PG8_SA(b, h) + aoff + m * 2048 + k * 1024); } while (0)
#define PG8_LDB(dst, b, h) do { _Pragma("unroll") for (int n = 0; n < 2; ++n) _Pragma("unroll") for (int k = 0; k < 2; ++k) dst[n][k] = *(const PG8_LAS bf16x8*)(lds + PG8_SB(b, h) + boff + n * 2048 + k * 1024); } while (0)
#define PG8_MMA(ai, bj, At, Bt) do { __builtin_amdgcn_s_setprio(1); _Pragma("unroll") for (int m = 0; m < 4; ++m) _Pragma("unroll") for (int n = 0; n < 2; ++n) _Pragma("unroll") for (int k = 0; k < 2; ++k) \
        acc[ai][bj][m][n] = __builtin_amdgcn_mfma_f32_16x16x32_bf16(Bt[n][k], At[m][k], acc[ai][bj][m][n], 0, 0, 0); __builtin_amdgcn_s_setprio(0); } while (0)
#define PG8_WAIT_V(n) asm volatile("s_waitcnt vmcnt(" #n ")" ::: "memory")
#define PG8_WAIT_L(n) asm volatile("s_waitcnt lgkmcnt(" #n ")" ::: "memory")
#define PG8_BAR __builtin_amdgcn_s_barrier()
#define PG8_SCHED __builtin_amdgcn_sched_barrier(0)
    Unit cur, nxt; int ui = 0;
    if (!S.next(0, cur)) return;
    f32x4 acc[2][2][4][2];
#pragma unroll
    for (int a = 0; a < 2; ++a)
#pragma unroll
        for (int b = 0; b < 2; ++b)
#pragma unroll
            for (int m = 0; m < 4; ++m)
#pragma unroll
                for (int n = 0; n < 2; ++n) acc[a][b][m][n] = (f32x4){0.f, 0.f, 0.f, 0.f};
    bf16x8 At[4][2], B0[2][2], B1[2][2];
    const char* cA = (const char*)g.A + (size_t)cur.pm * tstep; const char* cB = (const char*)g.Bt + (size_t)cur.pn * tstep;
    S.a_ready(cur);
    if constexpr (SP2) {
        PG8_STAGE(PG8_SB(0, 0), cB, voffB); PG8_STAGE(PG8_SB(0, 1), cB + hstep, voffB); PG8_STAGE(PG8_SA(0, 0), cA, voffA); PG8_STAGE(PG8_SA(0, 1), cA + hstep, voffA);
        if (wr == 1) PG8_BAR;
        PG8_WAIT_V(2); PG8_BAR;
        PG8_STAGE(PG8_SB(1, 0), cB + kstep, voffB); PG8_STAGE(PG8_SA(1, 0), cA + kstep, voffA); PG8_STAGE(PG8_SB(1, 1), cB + hstep + kstep, voffB);
        PG8_WAIT_V(6); PG8_BAR;
    } else {
        PG8_STAGE(PG8_SB(0, 0), cB, voffB); PG8_STAGE(PG8_SA(0, 0), cA, voffA); PG8_STAGE(PG8_SB(0, 1), cB + hstep, voffB); PG8_STAGE(PG8_SA(0, 1), cA + hstep, voffA);
        if (wr == 1) PG8_BAR;
        PG8_WAIT_V(4); PG8_BAR;
        PG8_STAGE(PG8_SB(1, 0), cB + kstep, voffB); PG8_STAGE(PG8_SA(1, 0), cA + kstep, voffA); PG8_STAGE(PG8_SB(1, 1), cB + hstep + kstep, voffB);
        PG8_WAIT_V(6); PG8_BAR;
    }
    for (;;) {
        const bool has_next = S.next(ui + 1, nxt);
        const char* nA = has_next ? (const char*)g.A + (size_t)nxt.pm * tstep : cA; const char* nB = has_next ? (const char*)g.Bt + (size_t)nxt.pn * tstep : cB;
        for (int t = 0; t < nt; t += 2) {
            const bool last = (t == nt - 2);
            const char* a1 = cA + (size_t)(t + 1) * kstep;
            const char* a2 = last ? nA : cA + (size_t)(t + 2) * kstep; const char* b2 = last ? nB : cB + (size_t)(t + 2) * kstep;
            const char* a3 = a2 + kstep; const char* b3 = b2 + kstep;
            if (last && has_next) S.a_ready(nxt);
            if constexpr (SP2) {
            PG8_LDB(B0, 0, 0); PG8_LDB(B1, 0, 1); PG8_SCHED; PG8_LDA(At, 0, 0); PG8_STAGE(PG8_SA(1, 1), a1 + hstep, voffA);
            PG8_WAIT_V(8); PG8_WAIT_L(0); PG8_BAR; PG8_MMA(0, 0, At, B0); PG8_MMA(0, 1, At, B1); PG8_BAR; PG8_SCHED;
            PG8_LDA(At, 0, 1); PG8_STAGE(PG8_SB(0, 0), b2, voffB); PG8_STAGE(PG8_SB(0, 1), b2 + hstep, voffB); PG8_STAGE(PG8_SA(0, 0), a2, voffA);
            PG8_WAIT_V(8); PG8_WAIT_L(0); PG8_BAR; PG8_MMA(1, 0, At, B0); PG8_MMA(1, 1, At, B1); PG8_BAR; PG8_SCHED;
            PG8_LDB(B0, 1, 0); PG8_LDB(B1, 1, 1); PG8_SCHED; PG8_LDA(At, 1, 0); PG8_STAGE(PG8_SA(0, 1), a2 + hstep, voffA);
            PG8_WAIT_V(8); PG8_WAIT_L(0); PG8_BAR; PG8_MMA(0, 0, At, B0); PG8_MMA(0, 1, At, B1); PG8_BAR; PG8_SCHED;
            PG8_LDA(At, 1, 1); PG8_STAGE(PG8_SB(1, 0), b3, voffB); PG8_STAGE(PG8_SB(1, 1), b3 + hstep, voffB); PG8_STAGE(PG8_SA(1, 0), a3, voffA);
            PG8_WAIT_V(8); PG8_WAIT_L(0); PG8_BAR; PG8_MMA(1, 0, At, B0); PG8_MMA(1, 1, At, B1); PG8_BAR; PG8_SCHED;
            } else {
            PG8_LDB(B0, 0, 0); PG8_SCHED; PG8_LDA(At, 0, 0); PG8_STAGE(PG8_SA(1, 1), a1 + hstep, voffA);
            PG8_WAIT_L(8); PG8_BAR; PG8_WAIT_L(0); PG8_MMA(0, 0, At, B0); PG8_BAR; PG8_SCHED;
            PG8_LDB(B1, 0, 1); PG8_STAGE(PG8_SB(0, 0), b2, voffB);
            PG8_BAR; PG8_WAIT_L(0); PG8_MMA(0, 1, At, B1); PG8_BAR;
            PG8_LDA(At, 0, 1); PG8_STAGE(PG8_SA(0, 0), a2, voffA);
            PG8_BAR; PG8_WAIT_L(0); PG8_MMA(1, 0, At, B0); PG8_BAR; PG8_SCHED;
            PG8_STAGE(PG8_SB(0, 1), b2 + hstep, voffB);
            PG8_WAIT_V(6); PG8_BAR; PG8_MMA(1, 1, At, B1); PG8_BAR;
            PG8_LDB(B0, 1, 0); PG8_SCHED; PG8_LDA(At, 1, 0); PG8_STAGE(PG8_SA(0, 1), a2 + hstep, voffA);
            PG8_WAIT_L(8); PG8_BAR; PG8_WAIT_L(0); PG8_MMA(0, 0, At, B0); PG8_BAR; PG8_SCHED;
            PG8_LDB(B1, 1, 1); PG8_STAGE(PG8_SB(1, 0), b3, voffB);
            PG8_BAR; PG8_WAIT_L(0); PG8_MMA(0, 1, At, B1); PG8_BAR;
            PG8_LDA(At, 1, 1); PG8_STAGE(PG8_SA(1, 0), a3, voffA);
            PG8_BAR; PG8_WAIT_L(0); PG8_MMA(1, 0, At, B0); PG8_BAR; PG8_SCHED;
            PG8_STAGE(PG8_SB(1, 1), b3 + hstep, voffB);
            PG8_WAIT_V(6); PG8_BAR; PG8_MMA(1, 1, At, B1); PG8_BAR;
            }
        }
        if constexpr (ALIGN_EPI) { if (wr == 0) PG8_BAR; }
        if constexpr (!Epi::AFTER_DRAIN) { E(acc, cur, wr, wc, fr, fq); S.done(cur); }
        if (!has_next) break;
#pragma unroll
        for (int a = 0; a < 2; ++a)
#pragma unroll
            for (int b = 0; b < 2; ++b)
#pragma unroll
                for (int m = 0; m < 4; ++m)
#pragma unroll
                    for (int n = 0; n < 2; ++n) acc[a][b][m][n] = (f32x4){0.f, 0.f, 0.f, 0.f};
        cur = nxt; cA = nA; cB = nB; ++ui;
        if constexpr (ALIGN_EPI) { if (wr == 1) PG8_BAR; }
    }
    PG8_WAIT_V(0);
    if constexpr (!ALIGN_EPI) { if (wr == 0) PG8_BAR; }
    PG8_BAR;
    if constexpr (Epi::AFTER_DRAIN) { E.fused(acc, cur, wr, wc, fr, fq, lds, wid, lane); S.done(cur); }
#undef PG8_SA
#undef PG8_SB
#undef PG8_STAGE
#undef PG8_LDA
#undef PG8_LDB
#undef PG8_MMA
#undef PG8_WAIT_V
#undef PG8_WAIT_L
#undef PG8_BAR
#undef PG8_SCHED
}
}

#define LAS __attribute__((address_space(3)))
typedef unsigned short bf16;
typedef short bf16x8 __attribute__((ext_vector_type(8)));
typedef float f32x4 __attribute__((ext_vector_type(4)));
typedef float f32x2 __attribute__((ext_vector_type(2)));
typedef unsigned u32x4 __attribute__((ext_vector_type(4)));
typedef unsigned u32x2 __attribute__((ext_vector_type(2)));

constexpr int NTHR = 512;
constexpr int DM = 2048, SEQ = 4096, CTX = 256, NLAT = 8192, MTOK = 8704, DFF = 8192;
constexpr int INC = 7200, LDP = 7424;
constexpr int NSC = 68;
constexpr int C_GQ = 0, C_GK = 256, C_GV = 512, C_GR = 1024, C_GA = 1536;
constexpr int C_HQ = 1568, C_HF = 2080, C_HI = 3104, C_HG = 3616;
constexpr int C_NQ = 4128, C_NK = 5152, C_NV = 6176;
constexpr size_t MiB = 1u << 20;
constexpr size_t WS_MOD = 1 * MiB;
constexpr size_t WS_ROPE = 1 * MiB + 512 * 1024;
constexpr size_t WS_WIN = 2 * MiB, SZ_WIN = 29 * MiB;
constexpr size_t WS_WOUT = WS_WIN + 2 * SZ_WIN, SZ_WOUT = 8 * MiB;
constexpr size_t WS_W1 = WS_WOUT + 2 * SZ_WOUT, SZ_W1 = 32 * MiB;
constexpr size_t WS_W2 = WS_W1 + 2 * SZ_W1, SZ_W2 = 32 * MiB;
constexpr size_t WS_H = WS_W2 + 2 * SZ_W2;
constexpr size_t WS_Y = WS_H + 34 * MiB;
constexpr size_t WS_X = WS_Y + 34 * MiB;
constexpr size_t WS_U = WS_X + 68 * MiB;
constexpr size_t WS_P = WS_U, WS_HID = WS_U;
constexpr size_t WS_STG = WS_U + 124 * MiB;
constexpr size_t WS_STH = WS_STG + 34 * MiB;
constexpr size_t WS_DCG = WS_STH + 68 * MiB;
constexpr size_t WS_DCH = WS_DCG + 1 * MiB;
constexpr size_t WS_END = WS_DCH + 1 * MiB;
constexpr int LDS_BYTES = 147456;

struct Args { const float* in[20]; float* out; unsigned char* ws; int ph_lo, ph_hi; };

__device__ __forceinline__ unsigned f2bf(float f) { unsigned u = __builtin_bit_cast(unsigned, f); return (u + 0x7fffu + ((u >> 16) & 1u)) >> 16; }
__device__ __forceinline__ unsigned pk2(float lo, float hi) { return f2bf(lo) | (f2bf(hi) << 16); }
__device__ __forceinline__ float bf2f(unsigned h) { return __builtin_bit_cast(float, h << 16); }
__device__ __forceinline__ float wave_sum(float v) {
#pragma unroll
    for (int o = 1; o < 64; o <<= 1) v += __shfl_xor(v, o);
    return v;
}
__device__ __forceinline__ float wave_max(float v) {
#pragma unroll
    for (int o = 1; o < 64; o <<= 1) v = fmaxf(v, __shfl_xor(v, o));
    return v;
}
__device__ __forceinline__ float sigmoid_f(float x) { return 1.f / (1.f + __expf(-x)); }
__device__ __forceinline__ float silu_f(float x) { return x / (1.f + __expf(-x)); }
__device__ __forceinline__ float logsig_f(float x) { return fminf(x, 0.f) - __logf(1.f + __expf(-fabsf(x))); }
__device__ __forceinline__ bf16x8 frag(const LAS bf16* base, int ld, int row0, int k0, int lane) {
    return *(const LAS bf16x8*)(base + (row0 + (lane & 15)) * ld + k0 + (lane >> 4) * 8);
}
#define MFMA16(a, b, c) __builtin_amdgcn_mfma_f32_16x16x32_bf16((a), (b), (c), 0, 0, 0)

__device__ __forceinline__ void p0_transpose_item(const float* W, int K, int N, bf16* WT, LAS float* scr, int item, int lane) {
    const int nblk = N / 32, kb = item / nblk, nb = item % nblk, k0 = 64 * kb, n0 = 32 * nb;
#pragma unroll 8
    for (int i = 0; i < 32; ++i) { const int kk = 2 * i + (lane >> 5); scr[kk * 33 + (lane & 31)] = W[(size_t)(k0 + kk) * N + n0 + (lane & 31)]; }
    asm volatile("s_waitcnt lgkmcnt(0)" ::: "memory");
    const int c = lane & 7;
#pragma unroll
    for (int j = 0; j < 4; ++j) { const int n = (lane >> 3) + 8 * j; const LAS float* s = scr + (8 * c) * 33 + n;
        u32x4 o; o.x = pk2(s[0 * 33], s[1 * 33]); o.y = pk2(s[2 * 33], s[3 * 33]); o.z = pk2(s[4 * 33], s[5 * 33]); o.w = pk2(s[6 * 33], s[7 * 33]);
        *(u32x4*)(WT + (size_t)(n0 + n) * K + k0 + 8 * c) = o; }
    asm volatile("s_waitcnt lgkmcnt(0)" ::: "memory");
}

__device__ __forceinline__ void p0_phase(const Args& a, LAS unsigned char* L, int tid, int lane, int wave, int bid, int G) {
    unsigned char* ws = a.ws;
    float* MOD = (float*)(ws + WS_MOD);
    {
        LAS float* sv = (LAS float*)L;
        LAS float* red = (LAS float*)(L + 24576);
        for (int i = tid; i < 3 * 2048; i += NTHR) { const int s = i >> 11, k = i & 2047; const float c = s < 2 ? a.in[1][s * 2048 + k] : a.in[3][k]; sv[i] = silu_f(c); }
        __syncthreads();
        for (int it = bid; it < 256; it += G) {
            const int l = it >> 7, n0 = (it & 127) * 96;
            const float* W = a.in[4] + (size_t)l * 2048 * 12288 + n0;
            const int cgp = tid % 24, rg = tid / 24;
            float acc[3][4];
#pragma unroll
            for (int s = 0; s < 3; ++s)
#pragma unroll
                for (int j = 0; j < 4; ++j) acc[s][j] = 0.f;
            if (rg < 21) {
#pragma unroll 4
                for (int k = rg; k < 2048; k += 21) {
                    const f32x4 w = *(const f32x4*)(W + (size_t)k * 12288 + cgp * 4);
                    const float s0 = sv[k], s1 = sv[2048 + k], s2 = sv[4096 + k];
#pragma unroll
                    for (int j = 0; j < 4; ++j) { acc[0][j] += s0 * w[j]; acc[1][j] += s1 * w[j]; acc[2][j] += s2 * w[j]; }
                }
#pragma unroll
                for (int s = 0; s < 3; ++s)
#pragma unroll
                    for (int j = 0; j < 4; ++j) red[(rg * 3 + s) * 96 + cgp * 4 + j] = acc[s][j];
            }
            __syncthreads();
            if (tid < 288) { const int s = tid / 96, ci = tid % 96; float t = 0.f;
                for (int r2 = 0; r2 < 21; ++r2) t += red[(r2 * 3 + s) * 96 + ci];
                MOD[(size_t)(l * 3 + s) * 12288 + n0 + ci] = t + a.in[5][l * 12288 + n0 + ci]; }
            __syncthreads();
        }
    }
    if (bid == 0) {
        for (int u = tid; u < 1024; u += NTHR) { const int pos = u >> 4, i = u & 15;
            const float inv = (float)exp2(-(double)i * (13.287712379549449 / 16.0));
            const double ang = (double)pos * (double)inv;
            const double kq = rint(ang * 0.15915494309189535);
            const float rr = (float)(ang - kq * 6.283185307179586);
            f32x2 cs; cs.x = cosf(rr); cs.y = sinf(rr);
            ((f32x2*)(ws + WS_ROPE))[u] = cs; }
    }
    {
        LAS float* scr = (LAS float*)(L + wave * 16384);
        const int gw = bid * 8 + wave, NGW = G * 8;
        constexpr int I_IN = 32 * 225, I_OUT = 32 * 64, I_1 = 32 * 256, I_2 = 128 * 64, I_L = I_IN + I_OUT + I_1 + I_2;
        for (int it = gw; it < 2 * I_L; it += NGW) {
            const int l = it / I_L; int r = it % I_L;
            if (r < I_IN) { p0_transpose_item(a.in[7] + (size_t)l * DM * INC, DM, INC, (bf16*)(ws + WS_WIN + l * SZ_WIN), scr, r, lane); continue; } r -= I_IN;
            if (r < I_OUT) { p0_transpose_item(a.in[16] + (size_t)l * DM * DM, DM, DM, (bf16*)(ws + WS_WOUT + l * SZ_WOUT), scr, r, lane); continue; } r -= I_OUT;
            if (r < I_1) { p0_transpose_item(a.in[18] + (size_t)l * DM * DFF, DM, DFF, (bf16*)(ws + WS_W1 + l * SZ_W1), scr, r, lane); continue; } r -= I_1;
            p0_transpose_item(a.in[19] + (size_t)l * DFF * DM, DFF, DM, (bf16*)(ws + WS_W2 + l * SZ_W2), scr, r, lane);
        }
    }
}

__device__ __forceinline__ void norm_phase(const float* xlat, const float* xctx, int nrows, const float* g, const float* modl, int sh_off, int sc_off, bf16* H, int lane, int gw, int NGW) {
    for (int row = gw; row < nrows; row += NGW) {
        const float* xr = row < NLAT ? xlat + (size_t)row * DM : xctx + (size_t)(row - NLAT) * DM;
        const int sg = row < NLAT ? (row >> 12) : 2;
        const float* sh = modl + sg * 12288 + sh_off; const float* sc = modl + sg * 12288 + sc_off;
        f32x4 v[8]; float ss = 0.f;
#pragma unroll
        for (int j = 0; j < 8; ++j) { v[j] = ((const f32x4*)xr)[lane + 64 * j]; ss += (v[j].x * v[j].x + v[j].y * v[j].y) + (v[j].z * v[j].z + v[j].w * v[j].w); }
        const float rstd = rsqrtf(wave_sum(ss) * (1.f / DM) + 1e-6f);
        u32x2* o8 = (u32x2*)(H + (size_t)row * DM);
#pragma unroll
        for (int j = 0; j < 8; ++j) { const int c4 = lane + 64 * j; const f32x4 g4 = ((const f32x4*)g)[c4], s4 = ((const f32x4*)sc)[c4], h4 = ((const f32x4*)sh)[c4];
            const f32x4 o = v[j] * rstd * g4 * (s4 + 1.f) + h4;
            u32x2 w; w.x = pk2(o.x, o.y); w.y = pk2(o.z, o.w); o8[c4] = w; }
    }
}

__device__ __forceinline__ void na_item(const Args& a, int l, const bf16* P, bf16* Y, int qrow0, int b, int h, int r, int nwin, LAS unsigned char* L, int tid, int lane, int wave) {
    LAS bf16* QN = (LAS bf16*)L;
    LAS bf16* KN = (LAS bf16*)(L + 17408);
    LAS bf16* VT = (LAS bf16*)(L + 34816);
    LAS bf16* PB = (LAS bf16*)(L + 53248);
    LAS float* LS = (LAS float*)(L + 62464);
    LAS float* RB = (LAS float*)(L + 62976);
    LAS float* MISC = (LAS float*)(L + 65024);
    const float* qn = a.in[13] + l * 128; const float* kn = a.in[14] + l * 128; const float* rpb = a.in[15] + (size_t)(l * 8 + h) * 465;
    const float qw0 = qn[lane * 2], qw1 = qn[lane * 2 + 1], kw0 = kn[lane * 2], kw1 = kn[lane * 2 + 1];
    for (int i = tid; i < 465; i += NTHR) RB[i] = rpb[i];
    if (wave == 0) {
        const float m1 = wave_max(fmaxf(fabsf(qw0), fabsf(qw1))), m2 = wave_max(fmaxf(fabsf(kw0), fabsf(kw1)));
        float m3 = 0.f; for (int i = lane; i < 465; i += 64) m3 = fmaxf(m3, fabsf(rpb[i]));
        m3 = wave_max(m3);
        if (lane == 0) MISC[0] = 11.313708499f * m1 * m2 + m3;
    }
    const int r0 = r - 4 < 0 ? 0 : (r - 4 > 56 ? 56 : r - 4);
#pragma unroll 2
    for (int rr = 0; rr < 8; ++rr) { const int i = wave * 8 + rr;
        const unsigned w = *(const unsigned*)(P + (size_t)(qrow0 + i) * LDP + C_NQ + h * 128 + lane * 2);
        const float x0 = bf2f(w & 0xffffu), x1 = bf2f(w >> 16);
        const float rstd = rsqrtf(wave_sum(x0 * x0 + x1 * x1) * (1.f / 128.f) + 1e-6f) * 0.08838834764831845f;
        *(LAS unsigned*)(QN + i * 136 + lane * 2) = pk2(x0 * rstd * qw0, x1 * rstd * qw1); }
    __syncthreads();
    const float shift = MISC[0];
    const int qt = wave & 3, wg2 = wave >> 2, quad = lane >> 4, l15 = lane & 15;
    f32x4 o[4]; float lsum[4];
#pragma unroll
    for (int t = 0; t < 4; ++t) { o[t] = (f32x4){0.f, 0.f, 0.f, 0.f}; lsum[t] = 0.f; }
    for (int kt = (nwin ? 0 : 8); kt < 12; ++kt) {
        const int krow0 = kt < 8 ? b * SEQ + (r0 + kt) * 64 : NLAT + b * CTX + (kt - 8) * 64;
#pragma unroll 2
        for (int rr = 0; rr < 8; ++rr) { const int j = wave * 8 + rr;
            const bf16* pr = P + (size_t)(krow0 + j) * LDP + h * 128 + lane * 2;
            const unsigned w = *(const unsigned*)(pr + C_NK), vv = *(const unsigned*)(pr + C_NV);
            const float x0 = bf2f(w & 0xffffu), x1 = bf2f(w >> 16);
            const float rstd = rsqrtf(wave_sum(x0 * x0 + x1 * x1) * (1.f / 128.f) + 1e-6f);
            *(LAS unsigned*)(KN + j * 136 + lane * 2) = pk2(x0 * rstd * kw0, x1 * rstd * kw1);
            VT[(lane * 2) * 72 + j] = (bf16)(vv & 0xffffu); VT[(lane * 2 + 1) * 72 + j] = (bf16)(vv >> 16); }
        __syncthreads();
#pragma unroll
        for (int t2 = 0; t2 < 2; ++t2) { const int ktile = wg2 * 2 + t2;
            f32x4 s = (f32x4){0.f, 0.f, 0.f, 0.f};
#pragma unroll
            for (int ks = 0; ks < 4; ++ks) s = MFMA16(frag(QN, 136, qt * 16, ks * 32, lane), frag(KN, 136, ktile * 16, ks * 32, lane), s);
            const int kc = ktile * 16 + l15;
#pragma unroll
            for (int jj = 0; jj < 4; ++jj) { const int q = qt * 16 + quad * 4 + jj;
                bool valid = true; float bias = 0.f;
                if (kt < 8) { const int cs = q - 8 < 0 ? 0 : (q - 8 > 48 ? 48 : q - 8); valid = (kc >= cs) && (kc < cs + 16);
                    if (valid) bias = RB[(r0 + kt - r + 7) * 31 + (kc - q + 15)]; }
                const float p = valid ? __expf(s[jj] + bias - shift) : 0.f;
                const unsigned pb = f2bf(p); lsum[jj] += bf2f(pb); PB[q * 72 + kc] = (bf16)pb; } }
        __syncthreads();
#pragma unroll
        for (int ks = 0; ks < 2; ++ks) { const bf16x8 af = frag(PB, 72, qt * 16, ks * 32, lane);
#pragma unroll
            for (int t = 0; t < 4; ++t) o[t] = MFMA16(af, frag(VT, 72, (wg2 * 4 + t) * 16, ks * 32, lane), o[t]); }
        __syncthreads();
    }
#pragma unroll
    for (int jj = 0; jj < 4; ++jj) { float v = lsum[jj]; v += __shfl_xor(v, 1); v += __shfl_xor(v, 2); v += __shfl_xor(v, 4); v += __shfl_xor(v, 8);
        if (l15 == 0) LS[wg2 * 64 + qt * 16 + quad * 4 + jj] = v; }
    __syncthreads();
#pragma unroll
    for (int jj = 0; jj < 4; ++jj) { const int q = qt * 16 + quad * 4 + jj; const float inv = 1.f / (LS[q] + LS[64 + q]);
        bf16* yr = Y + (size_t)(qrow0 + q) * DM + 1024 + h * 128 + wg2 * 64 + l15;
#pragma unroll
        for (int t = 0; t < 4; ++t) yr[t * 16] = (bf16)f2bf(o[t][jj] * inv); }
    __syncthreads();
}

template <int MX> __device__ __forceinline__ void load_qkg(const Args& a, int l, const bf16* P, int row0, int h, int seg, int c, int dir, bool need_q,
                                                             LAS float* QF, LAS float* KF, LAS float* CF, int tid) {
    if (MX == 0) {
        constexpr int DS = 65;
        const f32x2* rope = (const f32x2*)(a.ws + WS_ROPE);
        for (int u = tid; u < 2048; u += NTHR) { const int j = u >> 5, hf = (u >> 4) & 1, i = u & 15;
            const bf16* pr = P + (size_t)(row0 + j) * LDP + h * 64;
            const int d1 = hf * 32 + i, d2 = d1 + 16;
            float cs = 1.f, sn = 0.f;
            if (seg) { const f32x2 t = rope[(hf ? j : c) * 16 + i]; cs = t.x; sn = t.y; }
            if (need_q) { const float x1 = bf2f(pr[C_GQ + d1]) * 0.125f, x2 = bf2f(pr[C_GQ + d2]) * 0.125f; QF[j * DS + d1] = x1 * cs - x2 * sn; QF[j * DS + d2] = x1 * sn + x2 * cs; }
            { const float x1 = bf2f(pr[C_GK + d1]), x2 = bf2f(pr[C_GK + d2]); KF[j * DS + d1] = x1 * cs - x2 * sn; KF[j * DS + d2] = x1 * sn + x2 * cs; } }
        const float* w2 = a.in[8] + (size_t)((l * 2 + dir) * 16) * 256 + h * 64;
        const float* ba = a.in[9] + (l * 2 + dir) * 256 + h * 64;
        for (int u = tid; u < 4096; u += NTHR) { const int j = u >> 6, d = u & 63;
            const bf16* pr = P + (size_t)(row0 + j) * LDP + C_GA + dir * 16;
            float s = ba[d];
#pragma unroll
            for (int r2 = 0; r2 < 16; ++r2) s += bf2f(pr[r2]) * w2[r2 * 256 + d];
            CF[j * DS + d] = logsig_f(s) * (1.f / 16.f); }
    } else {
        constexpr int DS = 129;
        const float* hlb = a.in[11];
        for (int u = tid; u < 8192; u += NTHR) { const int j = u >> 7, d = u & 127;
            const bf16* pr = P + (size_t)(row0 + j) * LDP + h * 128 + d;
            if (need_q) QF[j * DS + d] = silu_f(bf2f(pr[C_HQ]));
            const float logit = bf2f(pr[C_HF + dir * 512]);
            float lb = 0.f;
            if (l == 1) { const float b0 = hlb[dir * 512 + h * 128 + d], b1 = hlb[(2 + dir) * 512 + h * 128 + d]; lb = 1.f / (1.f + __expf(b0 - b1)); }
            const float sg = sigmoid_f(logit);
            CF[j * DS + d] = __logf(lb + (1.f - lb) * sg);
            KF[j * DS + d] = (1.f - lb) / (1.f + __expf(logit)); }
    }
}
__device__ __forceinline__ void load_vt(const bf16* P, int row0, int vcol, LAS bf16* VT, int tid) {
    for (int u = tid; u < 4096; u += NTHR) { const int j = u >> 6, vp = u & 63;
        const unsigned w = *(const unsigned*)(P + (size_t)(row0 + j) * LDP + vcol + vp * 2);
        VT[(vp * 2) * 72 + j] = (bf16)(w & 0xffffu); VT[(vp * 2 + 1) * 72 + j] = (bf16)(w >> 16); }
}
template <int DK> __device__ __forceinline__ void cumsum64(LAS float* CF, LAS float* SG, int dir, int tid) {
    constexpr int DS = DK + 1, NSEG = NTHR / DK, SL = 64 / NSEG;
    const int d = tid % DK, sg = tid / DK;
    float run = 0.f;
#pragma unroll 4
    for (int p = 0; p < SL; ++p) { const int pp = sg * SL + p, j = dir ? 63 - pp : pp; run += CF[j * DS + d]; CF[j * DS + d] = run; }
    SG[sg * DK + d] = run;
    __syncthreads();
    float off = 0.f;
    for (int s2 = 0; s2 < sg; ++s2) off += SG[s2 * DK + d];
#pragma unroll 4
    for (int p = 0; p < SL; ++p) { const int pp = sg * SL + p, j = dir ? 63 - pp : pp; CF[j * DS + d] += off; }
    __syncthreads();
}
__device__ __forceinline__ int scan_chunk(int seg, int c, int dir) { return seg ? 4 + (dir ? 63 - c : c) : (dir ? 3 - c : c); }

template <int MX> __device__ __forceinline__ void s1_item(const Args& a, int l, const bf16* P, int bh, int seg, int c, int dir, LAS unsigned char* L, int tid, int lane, int wave) {
    constexpr int DK = MX ? 128 : 64, DS = DK + 1, NT = DK / 16;
    LAS float* KF = (LAS float*)L;
    LAS float* CF = (LAS float*)(L + 33024);
    LAS float* SG = (LAS float*)(L + 66048);
    LAS bf16* VT = (LAS bf16*)(L + 68096);
    LAS bf16* KT = (LAS bf16*)(L + 86528);
    const int b = bh >> 2, h = bh & 3;
    const int row0 = seg ? b * SEQ + c * 64 : NLAT + b * CTX + c * 64;
    load_qkg<MX>(a, l, P, row0, h, seg, c, dir, false, KF, KF, CF, tid);
    load_vt(P, row0, (MX ? C_HI : C_GV) + h * 128, VT, tid);
    __syncthreads();
    cumsum64<DK>(CF, SG, dir, tid);
    const int jl = dir ? 0 : 63;
    for (int u = tid; u < DK * 64; u += NTHR) { const int d = u % DK, j = u / DK;
        KT[d * 72 + j] = (bf16)f2bf(KF[j * DS + d] * __expf(CF[jl * DS + d] - CF[j * DS + d])); }
    const int sc = scan_chunk(seg, c, dir);
    const size_t sidx = (size_t)((bh * 2 + dir) * NSC + sc);
    float* ST = (float*)(a.ws + (MX ? WS_STH : WS_STG)) + sidx * (DK * 128);
    float* DC = (float*)(a.ws + (MX ? WS_DCH : WS_DCG)) + sidx * DK;
    if (tid < DK) DC[tid] = __expf(CF[jl * DS + tid]);
    __syncthreads();
    const int dt = wave % NT, vb = (wave / NT) * NT, quad = lane >> 4, l15 = lane & 15;
    f32x4 acc[NT];
#pragma unroll
    for (int t = 0; t < NT; ++t) acc[t] = (f32x4){0.f, 0.f, 0.f, 0.f};
#pragma unroll
    for (int ks = 0; ks < 2; ++ks) { const bf16x8 af = frag(KT, 72, dt * 16, ks * 32, lane);
#pragma unroll
        for (int t = 0; t < NT; ++t) acc[t] = MFMA16(af, frag(VT, 72, (vb + t) * 16, ks * 32, lane), acc[t]); }
#pragma unroll
    for (int t = 0; t < NT; ++t)
#pragma unroll
        for (int jj = 0; jj < 4; ++jj) ST[(dt * 16 + quad * 4 + jj) * 128 + (vb + t) * 16 + l15] = acc[t][jj];
    __syncthreads();
}

__device__ __forceinline__ void s2_phase(const Args& a, int gtid, int nthreads) {
    for (int e = gtid; e < 393216; e += nthreads) {
        float* st; const float* dc; int ss, sd;
        if (e < 131072) { const int sq = e >> 13, rem = e & 8191; st = (float*)(a.ws + WS_STG) + (size_t)sq * NSC * 8192 + rem; dc = (const float*)(a.ws + WS_DCG) + sq * NSC * 64 + (rem >> 7); ss = 8192; sd = 64; }
        else { const int e2 = e - 131072, sq = e2 >> 14, rem = e2 & 16383; st = (float*)(a.ws + WS_STH) + (size_t)sq * NSC * 16384 + rem; dc = (const float*)(a.ws + WS_DCH) + sq * NSC * 128 + (rem >> 7); ss = 16384; sd = 128; }
        float S = 0.f;
#pragma unroll 4
        for (int sc = 0; sc < NSC; ++sc) { const float Lv = st[(size_t)sc * ss], dv = dc[sc * sd]; st[(size_t)sc * ss] = S; S = dv * S + Lv; }
    }
}

template <int MX> __device__ __forceinline__ void s3_item(const Args& a, int l, const bf16* P, bf16* Y, int bh, int seg, int c, LAS unsigned char* L, int tid, int lane, int wave) {
    constexpr int DK = MX ? 128 : 64, DS = DK + 1, DB = DK + 8;
    LAS float* QF = (LAS float*)L;
    LAS float* KF = (LAS float*)(L + 33024);
    LAS float* CF = (LAS float*)(L + 66048);
    LAS bf16* QS = (LAS bf16*)(L + 33024);
    LAS bf16* S0T = (LAS bf16*)(L + 33024 + 17408);
    LAS bf16* ATT = (LAS bf16*)(L + 99072);
    LAS bf16* VT = (LAS bf16*)(L + 108288);
    LAS float* SG = (LAS float*)(L + 126720);
    LAS float* OF = (LAS float*)L;
    const int b = bh >> 2, h = bh & 3;
    const int row0 = seg ? b * SEQ + c * 64 : NLAT + b * CTX + c * 64;
    const int it_ = wave & 3, vb = (wave >> 2) * 4, quad = lane >> 4, l15 = lane & 15;
    f32x4 acc[4];
#pragma unroll
    for (int t = 0; t < 4; ++t) acc[t] = (f32x4){0.f, 0.f, 0.f, 0.f};
    load_vt(P, row0, (MX ? C_HI : C_GV) + h * 128, VT, tid);
#pragma unroll 1
    for (int dir = 0; dir < 2; ++dir) {
        load_qkg<MX>(a, l, P, row0, h, seg, c, dir, true, QF, KF, CF, tid);
        __syncthreads();
        cumsum64<DK>(CF, SG, dir, tid);
        {
            float pa[8];
#pragma unroll
            for (int jj = 0; jj < 8; ++jj) pa[jj] = 0.f;
            const int i = lane, jb = wave * 8;
#pragma unroll 2
            for (int d = 0; d < DK; ++d) { const float qi = QF[i * DS + d], ci = CF[i * DS + d];
#pragma unroll
                for (int jj = 0; jj < 8; ++jj) pa[jj] += qi * KF[(jb + jj) * DS + d] * __expf(fminf(ci - CF[(jb + jj) * DS + d], 0.f)); }
            unsigned pw[4];
#pragma unroll
            for (int jp = 0; jp < 4; ++jp) { const int j0 = jb + 2 * jp, j1 = j0 + 1;
                const bool v0 = dir ? (j0 >= i) : (j0 <= i), v1 = dir ? (j1 >= i) : (j1 <= i);
                pw[jp] = pk2(v0 ? pa[2 * jp] : 0.f, v1 ? pa[2 * jp + 1] : 0.f); }
            u32x4 w4; w4.x = pw[0]; w4.y = pw[1]; w4.z = pw[2]; w4.w = pw[3];
            *(LAS u32x4*)(ATT + i * 72 + jb) = w4;
        }
        __syncthreads();
        for (int u = tid; u < 64 * DK; u += NTHR) { const int j = u / DK, d = u % DK; QS[j * DB + d] = (bf16)f2bf(QF[j * DS + d] * __expf(CF[j * DS + d])); }
        __syncthreads();
        {
            const int sc = scan_chunk(seg, c, dir);
            const float* ST = (const float*)(a.ws + (MX ? WS_STH : WS_STG)) + (size_t)((bh * 2 + dir) * NSC + sc) * (DK * 128);
            for (int u = tid; u < DK * 32; u += NTHR) { const int d = u >> 5, v4 = (u & 31) * 4;
                const f32x4 s = *(const f32x4*)(ST + d * 128 + v4);
                S0T[(v4 + 0) * DB + d] = (bf16)f2bf(s.x); S0T[(v4 + 1) * DB + d] = (bf16)f2bf(s.y); S0T[(v4 + 2) * DB + d] = (bf16)f2bf(s.z); S0T[(v4 + 3) * DB + d] = (bf16)f2bf(s.w); }
        }
        __syncthreads();
#pragma unroll
        for (int ks = 0; ks < 2; ++ks) { const bf16x8 af = frag(ATT, 72, it_ * 16, ks * 32, lane);
#pragma unroll
            for (int t = 0; t < 4; ++t) acc[t] = MFMA16(af, frag(VT, 72, (vb + t) * 16, ks * 32, lane), acc[t]); }
#pragma unroll
        for (int ks = 0; ks < DK / 32; ++ks) { const bf16x8 af = frag(QS, DB, it_ * 16, ks * 32, lane);
#pragma unroll
            for (int t = 0; t < 4; ++t) acc[t] = MFMA16(af, frag(S0T, DB, (vb + t) * 16, ks * 32, lane), acc[t]); }
        __syncthreads();
    }
#pragma unroll
    for (int t = 0; t < 4; ++t)
#pragma unroll
        for (int jj = 0; jj < 4; ++jj) OF[(it_ * 16 + quad * 4 + jj) * 132 + (vb + t) * 16 + l15] = acc[t][jj];
    __syncthreads();
    const float* ng = (MX ? a.in[12] : a.in[10]) + l * 128;
    const float n0 = ng[lane * 2], n1 = ng[lane * 2 + 1];
    const int gcol = (MX ? C_HG : C_GR) + h * 128, ycol = (MX ? 512 : 0) + h * 128;
#pragma unroll 2
    for (int rr = 0; rr < 8; ++rr) { const int i = wave * 8 + rr;
        const float o0 = OF[i * 132 + lane * 2], o1 = OF[i * 132 + lane * 2 + 1];
        const float rstd = rsqrtf(wave_sum(o0 * o0 + o1 * o1) * (1.f / 128.f) + 1e-6f);
        const unsigned gw = *(const unsigned*)(P + (size_t)(row0 + i) * LDP + gcol + lane * 2);
        const float y0 = o0 * rstd * n0 * silu_f(bf2f(gw & 0xffffu)), y1 = o1 * rstd * n1 * silu_f(bf2f(gw >> 16));
        *(unsigned*)(Y + (size_t)(row0 + i) * DM + ycol + lane * 2) = pk2(y0, y1); }
    __syncthreads();
}

constexpr int NSTEPS = 19;
#define IN(s) (lo <= (s) && (s) < hi)
#define SEAM(s) do { if (IN(s) && IN((s) + 1)) cg::this_grid().sync(); } while (0)
template <int LYR> __device__ __forceinline__ void layer_program(const Args& a, LAS unsigned char* L, const int lo, const int hi) {
    constexpr int l = LYR;
    const int tid = threadIdx.x, lane = tid & 63, wave = __builtin_amdgcn_readfirstlane(tid >> 6);
    const int bid = blockIdx.x, G = gridDim.x;
    unsigned char* ws = a.ws;
        const int s0 = 1 + 9 * l;
        const bool last = (l == 1);
        const int mrows = last ? NLAT : MTOK;
        const float* modl = (const float*)(ws + WS_MOD) + (size_t)l * 3 * 12288;
        bf16* H = (bf16*)(ws + WS_H); bf16* Y = (bf16*)(ws + WS_Y); float* X = (float*)(ws + WS_X); bf16* P = (bf16*)(ws + WS_P); bf16* HID = (bf16*)(ws + WS_HID);
        if (IN(s0 + 0))
            norm_phase(l == 0 ? a.in[0] : X, l == 0 ? a.in[2] : X + (size_t)NLAT * DM, MTOK, a.in[6] + l * DM, modl, 0, 2048, H, lane, bid * 8 + wave, G * 8);
        SEAM(s0 + 0);
        if (IN(s0 + 1)) {
#ifndef NO_GEMM
            pg8::Gemm g{H, (const bf16*)(ws + WS_WIN + l * SZ_WIN), MTOK, LDP, DM}; pg8::StaticOrder S; S.init(MTOK, LDP, G, bid);
            pg8::EpiStoreBf16<0> E{P, LDP};
            pg8::gemm_phase<pg8::EpiStoreBf16<0>, pg8::StaticOrder, true, true>(L, g, S, E);
#endif
        }
        SEAM(s0 + 1);
        if (IN(s0 + 2)) {
            const int n_na = last ? 1024 : 1088;
            for (int it = bid; it < n_na + 2176; it += G) {
                if (it < n_na) {
#ifndef NO_NA
                    if (it < 1024) { const int b = it >> 9, h = (it >> 6) & 7, r = it & 63; na_item(a, l, P, Y, b * SEQ + r * 64, b, h, r, 8, L, tid, lane, wave); }
                    else { const int i2 = it - 1024, b = i2 >> 5, h = (i2 >> 2) & 7, qb = i2 & 3; na_item(a, l, P, Y, NLAT + b * CTX + qb * 64, b, h, 0, 0, L, tid, lane, wave); }
#endif
                } else {
                    const int i2 = it - n_na, mx = i2 / 1088, r1 = i2 % 1088, dir = r1 / 544, r2 = r1 % 544, bh = r2 / NSC, cc = r2 % NSC;
                    const int seg = cc >= 4, c = seg ? cc - 4 : cc;
#ifndef NO_S1
                    if (mx == 0) s1_item<0>(a, l, P, bh, seg, c, dir, L, tid, lane, wave); else s1_item<1>(a, l, P, bh, seg, c, dir, L, tid, lane, wave);
#endif
                }
            }
        }
        SEAM(s0 + 2);
        if (IN(s0 + 3)) s2_phase(a, bid * NTHR + tid, G * NTHR);
        SEAM(s0 + 3);
        if (IN(s0 + 4)) {
            for (int it = bid; it < 1088; it += G) {
                const int mx = it / 544, r2 = it % 544, bh = r2 / NSC, cc = r2 % NSC;
                const int seg = cc >= 4, c = seg ? cc - 4 : cc;
                if (last && !seg) continue;
#ifndef NO_S3
                if (mx == 0) s3_item<0>(a, l, P, Y, bh, seg, c, L, tid, lane, wave); else s3_item<1>(a, l, P, Y, bh, seg, c, L, tid, lane, wave);
#endif
            }
        }
        SEAM(s0 + 4);
        if (IN(s0 + 5)) {
#ifndef NO_GEMM
            pg8::Gemm g{Y, (const bf16*)(ws + WS_WOUT + l * SZ_WOUT), mrows, DM, DM}; pg8::StaticOrder S; S.init(mrows, DM, G, bid);
            pg8::EpiResGate E{l == 0 ? a.in[0] : X, l == 0 ? a.in[2] : X + (size_t)NLAT * DM, X, X + (size_t)NLAT * DM, modl + 4096};
            pg8::gemm_phase<pg8::EpiResGate, pg8::StaticOrder, true, true>(L, g, S, E);
#endif
        }
        SEAM(s0 + 5);
        if (IN(s0 + 6))
            norm_phase(X, X + (size_t)NLAT * DM, mrows, a.in[17] + l * DM, modl, 6144, 8192, H, lane, bid * 8 + wave, G * 8);
        SEAM(s0 + 6);
        if (IN(s0 + 7)) {
#ifndef NO_GEMM
            pg8::Gemm g{H, (const bf16*)(ws + WS_W1 + l * SZ_W1), mrows, DFF, DM}; pg8::StaticOrder S; S.init(mrows, DFF, G, bid);
            pg8::EpiStoreBf16<2> E{HID, DFF};
            pg8::gemm_phase<pg8::EpiStoreBf16<2>, pg8::StaticOrder, true, true>(L, g, S, E);
#endif
        }
        SEAM(s0 + 7);
        if (IN(s0 + 8)) {
#ifndef NO_GEMM
            pg8::Gemm g{HID, (const bf16*)(ws + WS_W2 + l * SZ_W2), mrows, DM, DFF}; pg8::StaticOrder S; S.init(mrows, DM, G, bid);
            pg8::EpiResGate E{X, X + (size_t)NLAT * DM, last ? a.out : X, X + (size_t)NLAT * DM, modl + 10240};
            pg8::gemm_phase<pg8::EpiResGate, pg8::StaticOrder, true, true>(L, g, S, E);
#endif
        }
        SEAM(s0 + 8);
    }
__global__ void __launch_bounds__(NTHR, 2) mk_fwd(Args a) {
    extern __shared__ __attribute__((aligned(16))) unsigned char lds_raw[];
    LAS unsigned char* L = (LAS unsigned char*)lds_raw;
    const int lo = a.ph_lo, hi = a.ph_hi;
    if (IN(0)) {
#ifndef NO_P0
        const int tid = threadIdx.x;
        p0_phase(a, L, tid, tid & 63, __builtin_amdgcn_readfirstlane(tid >> 6), blockIdx.x, gridDim.x);
#endif
    }
    SEAM(0);
    layer_program<0>(a, L, lo, hi);
    layer_program<1>(a, L, lo, hi);
}
#undef IN
#undef SEAM

extern "C" void kernel_launch(void* const* d_in, const int* in_sizes, int n_in, void* d_out, int out_size, void* d_ws, size_t ws_size, hipStream_t stream) {
    static int grid = 0;
    if (grid == 0) {
        if (n_in != 20 || ws_size < WS_END) { fprintf(stderr, "kernel_launch: expected 20 inputs and >= %zu bytes of workspace (got %d, %zu)\n", (size_t)WS_END, n_in, ws_size); grid = -1; return; }
        int dev = 0, cus = 0, per_cu = 0;
        (void)hipGetDevice(&dev); (void)hipDeviceGetAttribute(&cus, hipDeviceAttributeMultiprocessorCount, dev);
        if (hipFuncSetAttribute((const void*)mk_fwd, hipFuncAttributeMaxDynamicSharedMemorySize, LDS_BYTES) != hipSuccess) { fprintf(stderr, "kernel_launch: hipFuncSetAttribute failed\n"); grid = -1; return; }
        if (hipOccupancyMaxActiveBlocksPerMultiprocessor(&per_cu, (const void*)mk_fwd, NTHR, LDS_BYTES) != hipSuccess || per_cu < 1) { fprintf(stderr, "kernel_launch: occupancy query gave %d\n", per_cu); per_cu = 1; }
        (void)hipGetLastError();
        grid = cus * per_cu;
        if (grid > 256) grid = 256;
    }
    if (grid < 0) return;
    Args a{};
    for (int i = 0; i < 20; ++i) a.in[i] = (const float*)d_in[i];
    a.out = (float*)d_out; a.ws = (unsigned char*)d_ws;
#if MK_ONE_LAUNCH
    a.ph_lo = 0; a.ph_hi = NSTEPS;
    void* args[] = {&a};
    hipError_t e = hipLaunchCooperativeKernel((const void*)mk_fwd, dim3(grid), dim3(NTHR), args, LDS_BYTES, stream);
    if (e != hipSuccess) fprintf(stderr, "kernel_launch: cooperative launch failed: %s (grid %d)\n", hipGetErrorString(e), grid);
#else
    for (int s = 0; s < NSTEPS; ++s) { a.ph_lo = s; a.ph_hi = s + 1; hipLaunchKernelGGL(mk_fwd, dim3(grid), dim3(NTHR), LDS_BYTES, stream, a); }
#endif
}
```

```cpp
#include <hip/hip_runtime.h>
#include <hip/hip_cooperative_groups.h>
#include <cstdio>
#include <cstdint>
namespace cg = cooperative_groups;
#ifndef MK_ONE_LAUNCH
#define MK_ONE_LAUNCH 1
#endif
namespace pg8 {
#define PG8_LAS __attribute__((address_space(3)))
typedef unsigned short bf16_t;
typedef short bf16x8 __attribute__((ext_vector_type(8)));
typedef float f32x4 __attribute__((ext_vector_type(4)));
typedef unsigned u32x4 __attribute__((ext_vector_type(4)));
constexpr int BM = 256, BK = 64, HALF = 128, HTB = HALF * BK * 2  , STAGE_BYTES = 8 * HTB, NXCD = 8, WGM = 8;

__host__ __device__ __forceinline__ int lds_byte(int r, int c) { const int st = (r >> 4) * 2 + (c >> 5), rr = r & 15, cc = c & 31, ob = rr * 64 + cc * 2; return st * 1024 + (ob ^ (((ob >> 9) & 1) << 5)); }
__host__ __device__ __forceinline__ void stage_rc(int b, int& R, int& C) { const int st = b / 1024, sb = b % 1024, swz = sb ^ (((sb >> 9) & 1) << 5); R = (st >> 1) * 16 + swz / 64; C = (st & 1) * 32 + (swz % 64) / 2; }
__host__ __device__ __forceinline__ int perm32(int rho) { const int n = rho >> 4, i = rho & 15; return 8 * (i >> 2) + 4 * n + (i & 3); }

struct Unit { int pm, pn; };
struct Gemm { const bf16_t* A; const bf16_t* Bt; int M, N, K; };

struct StaticOrder {
    int nM, nN, nwg, G, c;
    __host__ __device__ void init(int M, int N, int G_, int c_) { nM = M / BM; nN = N / BM; nwg = nM * nN; G = G_; c = c_; }
    __host__ __device__ bool next(int i, Unit& u) const {
        const long L = (long)i * G + c; if (L >= nwg) return false;
        int wgid = (int)L; { const int q = nwg / NXCD, r = nwg % NXCD, xcd = wgid % NXCD, off = wgid / NXCD; wgid = (xcd < r ? xcd * (q + 1) : r * (q + 1) + (xcd - r) * q) + off; }
        const int nig = WGM * nN, gid = wgid / nig, fm = gid * WGM, gsz = (nM - fm) < WGM ? (nM - fm) : WGM;
        u.pm = fm + ((wgid % nig) % gsz); u.pn = (wgid % nig) / gsz; return true;
    }
    __device__ __forceinline__ void a_ready(const Unit&) const {}
    __device__ __forceinline__ void done(const Unit&) const {}
};

__device__ __forceinline__ unsigned cvt_pk_bf16(float lo, float hi) { unsigned r; asm volatile("v_cvt_pk_bf16_f32 %0, %1, %2" : "=v"(r) : "v"(lo), "v"(hi)); return r; }
template <int ACT  > struct EpiStoreBf16 {
    static constexpr bool PERM = true, AFTER_DRAIN = false;
    bf16_t* O; int ldc;
    __device__ __forceinline__ void operator()(const f32x4 (&acc)[2][2][4][2], const Unit& u, int wr, int wc, int fr, int fq) const {
        asm volatile("s_nop 7\n\ts_nop 7\n\ts_nop 7" ::: "memory");
        const int row0 = u.pm * BM + wr * 64 + fr; const int col0 = u.pn * BM + wc * 32 + 8 * fq;
#pragma unroll
        for (int ai = 0; ai < 2; ++ai)
#pragma unroll
            for (int m = 0; m < 4; ++m) { bf16_t* rowp = O + (size_t)(row0 + ai * HALF + m * 16) * ldc + col0;
#pragma unroll
                for (int bj = 0; bj < 2; ++bj) { f32x4 v0 = acc[ai][bj][m][0], v1 = acc[ai][bj][m][1];
                    if (ACT == 2) {
#pragma unroll
                        for (int e = 0; e < 4; ++e) { float a0 = v0[e] > 0.f ? v0[e] : 0.f, a1 = v1[e] > 0.f ? v1[e] : 0.f; v0[e] = a0 * a0; v1[e] = a1 * a1; } }
                    u32x4 w; w.x = cvt_pk_bf16(v0[0], v0[1]); w.y = cvt_pk_bf16(v0[2], v0[3]); w.z = cvt_pk_bf16(v1[0], v1[1]); w.w = cvt_pk_bf16(v1[2], v1[3]);
                    *(u32x4*)(rowp + bj * HALF) = w; } }
    }
};
template <int RT, int OT> struct EpiResGateT {
    static constexpr bool PERM = true, AFTER_DRAIN = false;
    const void* res; void* out; const float* gate;
    static __device__ __forceinline__ f32x4 lo4(const u32x4& w) { f32x4 r; r.x = __builtin_bit_cast(float, w.x << 16); r.y = __builtin_bit_cast(float, w.x & 0xffff0000u); r.z = __builtin_bit_cast(float, w.y << 16); r.w = __builtin_bit_cast(float, w.y & 0xffff0000u); return r; }
    static __device__ __forceinline__ f32x4 hi4(const u32x4& w) { f32x4 r; r.x = __builtin_bit_cast(float, w.z << 16); r.y = __builtin_bit_cast(float, w.z & 0xffff0000u); r.z = __builtin_bit_cast(float, w.w << 16); r.w = __builtin_bit_cast(float, w.w & 0xffff0000u); return r; }
    __device__ __forceinline__ void operator()(const f32x4 (&acc)[2][2][4][2], const Unit& u, int wr, int wc, int fr, int fq) const {
        const int rt = u.pm * BM; const float* g = gate + (rt >> 12) * 12288;
        const int lr0 = rt + wr * 64 + fr, col0 = u.pn * BM + wc * 32 + 8 * fq;
#pragma unroll
        for (int bj = 0; bj < 2; ++bj) {
            const f32x4 gv0 = *(const f32x4*)(g + col0 + bj * HALF), gv1 = *(const f32x4*)(g + col0 + bj * HALF + 4);
            if (RT == 1) {
                u32x4 rw[2][4];
#pragma unroll
                for (int ai = 0; ai < 2; ++ai)
#pragma unroll
                    for (int m = 0; m < 4; ++m) rw[ai][m] = *(const u32x4*)((const bf16_t*)res + (size_t)(lr0 + ai * HALF + m * 16) * 2048 + col0 + bj * HALF);
#pragma unroll
                for (int ai = 0; ai < 2; ++ai)
#pragma unroll
                    for (int m = 0; m < 4; ++m) { const size_t off = (size_t)(lr0 + ai * HALF + m * 16) * 2048 + col0 + bj * HALF;
                        const f32x4 v0 = lo4(rw[ai][m]) + gv0 * acc[ai][bj][m][0], v1 = hi4(rw[ai][m]) + gv1 * acc[ai][bj][m][1];
                        if (OT == 0) { float* op = (float*)out + off; *(f32x4*)op = v0; *(f32x4*)(op + 4) = v1; }
                        else { u32x4 w; w.x = cvt_pk_bf16(v0[0], v0[1]); w.y = cvt_pk_bf16(v0[2], v0[3]); w.z = cvt_pk_bf16(v1[0], v1[1]); w.w = cvt_pk_bf16(v1[2], v1[3]);
                            *(u32x4*)((bf16_t*)out + off) = w; } }
            } else {
#pragma unroll
                for (int ai = 0; ai < 2; ++ai) {
                    f32x4 r[4][2];
#pragma unroll
                    for (int m = 0; m < 4; ++m) { const float* rp = (const float*)res + (size_t)(lr0 + ai * HALF + m * 16) * 2048 + col0 + bj * HALF; r[m][0] = *(const f32x4*)rp; r[m][1] = *(const f32x4*)(rp + 4); }
#pragma unroll
                    for (int m = 0; m < 4; ++m) { const size_t off = (size_t)(lr0 + ai * HALF + m * 16) * 2048 + col0 + bj * HALF;
                        const f32x4 v0 = r[m][0] + gv0 * acc[ai][bj][m][0], v1 = r[m][1] + gv1 * acc[ai][bj][m][1];
                        if (OT == 0) { float* op = (float*)out + off; *(f32x4*)op = v0; *(f32x4*)(op + 4) = v1; }
                        else { u32x4 w; w.x = cvt_pk_bf16(v0[0], v0[1]); w.y = cvt_pk_bf16(v0[2], v0[3]); w.z = cvt_pk_bf16(v1[0], v1[1]); w.w = cvt_pk_bf16(v1[2], v1[3]);
                            *(u32x4*)((bf16_t*)out + off) = w; } }
                }
            }
        }
    }
};
template <class Epi, class Sched, bool ALIGN_EPI = false, bool SP2 = false>
__device__ __forceinline__ void gemm_phase(PG8_LAS unsigned char* lds, const Gemm g, const Sched& S, const Epi& E) {
    const int tid = threadIdx.x, wid = __builtin_amdgcn_readfirstlane(tid >> 6), lane = tid & 63, wr = wid >> 2, wc = wid & 3, fr = lane & 15, fq = lane >> 4;
    const int K = g.K, nt = K / BK;
    unsigned voffA[2], voffB[2];
#pragma unroll
    for (int i = 0; i < 2; ++i) { int R, C; stage_rc(tid * 16 + i * 8192, R, C); const int Rb = Epi::PERM ? ((R & ~31) + perm32(R & 31)) : R;
        voffA[i] = (unsigned)(R * K + C) * 2u; voffB[i] = (unsigned)(Rb * K + C) * 2u; }
    const size_t kstep = (size_t)(BK * 2);
    const size_t hstep = (size_t)HALF * K * 2;
    const size_t tstep = 2 * hstep;
    const unsigned ldsw = (unsigned)wid * 1024u;
    const int aoff = lds_byte(wr * 64 + fr, fq * 8), boff = lds_byte(wc * 32 + fr, fq * 8);
#define PG8_SA(b, h) (((b) * 2 + (h)) * HTB)
#define PG8_SB(b, h) ((4 + (b) * 2 + (h)) * HTB)
#define PG8_STAGE(bufoff, gbase, voff) do { _Pragma("unroll") for (int _i = 0; _i < 2; ++_i) \
        __builtin_amdgcn_global_load_lds((const unsigned*)((const char*)(gbase) + (voff)[_i]), (PG8_LAS unsigned*)(lds + (bufoff) + ldsw + _i * 8192), 16, 0, 0); } while (0)
#define PG8_LDA(dst, b, h) do { _Pragma("unroll") for (int m = 0; m < 4; ++m) _Pragma("unroll") for (int k = 0; k < 2; ++k) dst[m][k] = *(const PG8_LAS bf16x8*)(lds + PG8_SA(b, h) + aoff + m * 2048 + k * 1024); } while (0)
#define PG8_LDB(dst, b, h) do { _Pragma("unroll") for (int n = 0; n < 2; ++n) _Pragma("unroll") for (int k = 0; k < 2; ++k) dst[n][k] = *(const PG8_LAS bf16x8*)(lds + PG8_SB(b, h) + boff + n * 2048 + k * 1024); } while (0)
#define PG8_MMA(ai, bj, At, Bt) do { __builtin_amdgcn_s_setprio(1); _Pragma("unroll") for (int m = 0; m < 4; ++m) _Pragma("unroll") for (int n = 0; n < 2; ++n) _Pragma("unroll") for (int k = 0; k < 2; ++k) \
        acc[ai][bj][m][n] = __builtin_amdgcn_mfma_f32_16x16x32_bf16(Bt[n][k], At[m][k], acc[ai][bj][m][n], 0, 0, 0); __builtin_amdgcn_s_setprio(0); } while (0)
#define PG8_WAIT_V(n) asm volatile("s_waitcnt vmcnt(" #n ")" ::: "memory")
#define PG8_WAIT_L(n) asm volatile("s_waitcnt lgkmcnt(" #n ")" ::: "memory")
#define PG8_BAR __builtin_amdgcn_s_barrier()
#define PG8_SCHED __builtin_amdgcn_sched_barrier(0)
    Unit cur, nxt; int ui = 0;
    if (!S.next(0, cur)) return;
    f32x4 acc[2][2][4][2];
#pragma unroll
    for (int a = 0; a < 2; ++a)
#pragma unroll
        for (int b = 0; b < 2; ++b)
#pragma unroll
            for (int m = 0; m < 4; ++m)
#pragma unroll
                for (int n = 0; n < 2; ++n) acc[a][b][m][n] = (f32x4){0.f, 0.f, 0.f, 0.f};
    bf16x8 At[4][2], B0[2][2], B1[2][2];
    const char* cA = (const char*)g.A + (size_t)cur.pm * tstep; const char* cB = (const char*)g.Bt + (size_t)cur.pn * tstep;
    S.a_ready(cur);
    if constexpr (SP2) {
        PG8_STAGE(PG8_SB(0, 0), cB, voffB); PG8_STAGE(PG8_SB(0, 1), cB + hstep, voffB); PG8_STAGE(PG8_SA(0, 0), cA, voffA); PG8_STAGE(PG8_SA(0, 1), cA + hstep, voffA);
        if (wr == 1) PG8_BAR;
        PG8_WAIT_V(2); PG8_BAR;
        PG8_STAGE(PG8_SB(1, 0), cB + kstep, voffB); PG8_STAGE(PG8_SA(1, 0), cA + kstep, voffA); PG8_STAGE(PG8_SB(1, 1), cB + hstep + kstep, voffB);
        PG8_WAIT_V(6); PG8_BAR;
    } else {
        PG8_STAGE(PG8_SB(0, 0), cB, voffB); PG8_STAGE(PG8_SA(0, 0), cA, voffA); PG8_STAGE(PG8_SB(0, 1), cB + hstep, voffB); PG8_STAGE(PG8_SA(0, 1), cA + hstep, voffA);
        if (wr == 1) PG8_BAR;
        PG8_WAIT_V(4); PG8_BAR;
        PG8_STAGE(PG8_SB(1, 0), cB + kstep, voffB); PG8_STAGE(PG8_SA(1, 0), cA + kstep, voffA); PG8_STAGE(PG8_SB(1, 1), cB + hstep + kstep, voffB);
        PG8_WAIT_V(6); PG8_BAR;
    }
    for (;;) {
        const bool has_next = S.next(ui + 1, nxt);
        const char* nA = has_next ? (const char*)g.A + (size_t)nxt.pm * tstep : cA; const char* nB = has_next ? (const char*)g.Bt + (size_t)nxt.pn * tstep : cB;
        for (int t = 0; t < nt; t += 2) {
            const bool last = (t == nt - 2);
            const char* a1 = cA + (size_t)(t + 1) * kstep;
            const char* a2 = last ? nA : cA + (size_t)(t + 2) * kstep; const char* b2 = last ? nB : cB + (size_t)(t + 2) * kstep;
            const char* a3 = a2 + kstep; const char* b3 = b2 + kstep;
            if (last && has_next) S.a_ready(nxt);
            if constexpr (SP2) {
            PG8_LDB(B0, 0, 0); PG8_LDB(B1, 0, 1); PG8_SCHED; PG8_LDA(At, 0, 0); PG8_STAGE(PG8_SA(1, 1), a1 + hstep, voffA);
            PG8_WAIT_V(8); PG8_WAIT_L(0); PG8_BAR; PG8_MMA(0, 0, At, B0); PG8_MMA(0, 1, At, B1); PG8_BAR; PG8_SCHED;
            PG8_LDA(At, 0, 1); PG8_STAGE(PG8_SB(0, 0), b2, voffB); PG8_STAGE(PG8_SB(0, 1), b2 + hstep, voffB); PG8_STAGE(PG8_SA(0, 0), a2, voffA);
            PG8_WAIT_V(8); PG8_WAIT_L(0); PG8_BAR; PG8_MMA(1, 0, At, B0); PG8_MMA(1, 1, At, B1); PG8_BAR; PG8_SCHED;
            PG8_LDB(B0, 1, 0); PG8_LDB(B1, 1, 1); PG8_SCHED; PG8_LDA(At, 1, 0); PG8_STAGE(PG8_SA(0, 1), a2 + hstep, voffA);
            PG8_WAIT_V(8); PG8_WAIT_L(0); PG8_BAR; PG8_MMA(0, 0, At, B0); PG8_MMA(0, 1, At, B1); PG8_BAR; PG8_SCHED;
            PG8_LDA(At, 1, 1); PG8_STAGE(PG8_SB(1, 0), b3, voffB); PG8_STAGE(PG8_SB(1, 1), b3 + hstep, voffB); PG8_STAGE(PG8_SA(1, 0), a3, voffA);
            PG8_WAIT_V(8); PG8_WAIT_L(0); PG8_BAR; PG8_MMA(1, 0, At, B0); PG8_MMA(1, 1, At, B1); PG8_BAR; PG8_SCHED;
            } else {
            PG8_LDB(B0, 0, 0); PG8_SCHED; PG8_LDA(At, 0, 0); PG8_STAGE(PG8_SA(1, 1), a1 + hstep, voffA);
            PG8_WAIT_L(8); PG8_BAR; PG8_WAIT_L(0); PG8_MMA(0, 0, At, B0); PG8_BAR; PG8_SCHED;
            PG8_LDB(B1, 0, 1); PG8_STAGE(PG8_SB(0, 0), b2, voffB);
            PG8_BAR; PG8_WAIT_L(0); PG8_MMA(0, 1, At, B1); PG8_BAR;
            PG8_LDA(At, 0, 1); PG8_STAGE(PG8_SA(0, 0), a2, voffA);
            PG8_BAR; PG8_WAIT_L(0); PG8_MMA(1, 0, At, B0); PG8_BAR; PG8_SCHED;
            PG8_STAGE(PG8_SB(0, 1), b2 + hstep, voffB);
            PG8_WAIT_V(6); PG8_BAR; PG8_MMA(1, 1, At, B1); PG8_BAR;
            PG8_LDB(B0, 1, 0); PG8_SCHED; PG8_LDA(At, 1, 0); PG8_STAGE(PG8_SA(0, 1), a2 + hstep, voffA);
            PG8_WAIT_L(8); PG8_BAR; PG8_WAIT_L(0); PG8_MMA(0, 0, At, B0); PG8_BAR; PG8_SCHED;
            PG8_LDB(B1, 1, 1); PG8_STAGE(PG8_SB(1, 0), b3, voffB);
            PG8_BAR; PG8_WAIT_L(0); PG8_MMA(0, 1, At, B1); PG8_BAR;
            PG8_LDA(At, 1, 1); PG8_STAGE(PG8_SA(1, 0), a3, voffA);
            PG8_BAR; PG8_WAIT_L(0); PG8_MMA(1, 0, At, B0); PG8_BAR; PG8_SCHED;
            PG8_STAGE(PG8_SB(1, 1), b3 + hstep, voffB);
            PG8_WAIT_V(6); PG8_BAR; PG8_MMA(1, 1, At, B1); PG8_BAR;
            }
        }
        if constexpr (ALIGN_EPI) { if (wr == 0) PG8_BAR; }
        if constexpr (!Epi::AFTER_DRAIN) { E(acc, cur, wr, wc, fr, fq); S.done(cur); }
        if (!has_next) break;
#pragma unroll
        for (int a = 0; a < 2; ++a)
#pragma unroll
            for (int b = 0; b < 2; ++b)
#pragma unroll
                for (int m = 0; m < 4; ++m)
#pragma unroll
                    for (int n = 0; n < 2; ++n) acc[a][b][m][n] = (f32x4){0.f, 0.f, 0.f, 0.f};
        cur = nxt; cA = nA; cB = nB; ++ui;
        if constexpr (ALIGN_EPI) { if (wr == 1) PG8_BAR; }
    }
    PG8_WAIT_V(0);
    if constexpr (!ALIGN_EPI) { if (wr == 0) PG8_BAR; }
    PG8_BAR;
    if constexpr (Epi::AFTER_DRAIN) { E.fused(acc, cur, wr, wc, fr, fq, lds, wid, lane); S.done(cur); }
#undef PG8_SA
#undef PG8_SB
#undef PG8_STAGE
#undef PG8_LDA
#undef PG8_LDB
#undef PG8_MMA
#undef PG8_WAIT_V
#undef PG8_WAIT_L
#undef PG8_BAR
#undef PG8_SCHED
}
}

#define LAS __attribute__((address_space(3)))
typedef unsigned short bf16;
typedef short bf16x8 __attribute__((ext_vector_type(8)));
typedef float f32x4 __attribute__((ext_vector_type(4)));
typedef float f32x2 __attribute__((ext_vector_type(2)));
typedef unsigned u32x4 __attribute__((ext_vector_type(4)));
typedef unsigned u32x2 __attribute__((ext_vector_type(2)));

constexpr int NTHR = 512;
constexpr int DM = 2048, SEQ = 4096, CTX = 256, NLAT = 8192, MTOK = 8704, DFF = 8192;
constexpr int INC = 7200, LDP = 7424;
constexpr int NSC = 68;
constexpr int C_GQ = 0, C_GK = 256, C_GV = 512, C_GR = 1024, C_GA = 1536;
constexpr int C_HQ = 1568, C_HF = 2080, C_HI = 3104, C_HG = 3616;
constexpr int C_NQ = 4128, C_NK = 5152, C_NV = 6176;
constexpr size_t MiB = 1u << 20;
constexpr size_t WS_MOD = 1 * MiB;
constexpr size_t WS_ROPE = 1 * MiB + 512 * 1024;
constexpr size_t WS_WIN = 2 * MiB, SZ_WIN = 29 * MiB;
constexpr size_t WS_WOUT = WS_WIN + 2 * SZ_WIN, SZ_WOUT = 8 * MiB;
constexpr size_t WS_W1 = WS_WOUT + 2 * SZ_WOUT, SZ_W1 = 32 * MiB;
constexpr size_t WS_W2 = WS_W1 + 2 * SZ_W1, SZ_W2 = 32 * MiB;
constexpr size_t WS_H = WS_W2 + 2 * SZ_W2;
constexpr size_t WS_Y = WS_H + 34 * MiB;
constexpr size_t WS_X = WS_Y + 34 * MiB;
constexpr size_t WS_U = WS_X + 68 * MiB;
constexpr size_t WS_P = WS_U, WS_HID = WS_U;
constexpr size_t WS_STG = WS_U + 124 * MiB;
constexpr size_t WS_STH = WS_STG + 34 * MiB;
constexpr size_t WS_DCG = WS_STH + 68 * MiB;
constexpr size_t WS_DCH = WS_DCG + 1 * MiB;
constexpr size_t WS_SBG = WS_DCH + 1 * MiB;
constexpr size_t WS_SBH = WS_SBG + 17 * MiB;
constexpr size_t WS_PART = WS_SBH + 34 * MiB;
constexpr size_t WS_END = WS_PART + 16 * MiB;
constexpr int LDS_BYTES = 147456, LDS_MISC = 147328;
constexpr size_t CTL_ZERO_BYTES = 65536;

struct Args { const float* in[20]; float* out; unsigned char* ws; int ph_lo, ph_hi; };

__device__ __forceinline__ unsigned f2bf(float f) { unsigned u = __builtin_bit_cast(unsigned, f); return (u + 0x7fffu + ((u >> 16) & 1u)) >> 16; }
__device__ __forceinline__ unsigned pk2(float lo, float hi) { return f2bf(lo) | (f2bf(hi) << 16); }
__device__ __forceinline__ float bf2f(unsigned h) { return __builtin_bit_cast(float, h << 16); }
__device__ __forceinline__ float wave_sum(float v) {
#pragma unroll
    for (int o = 1; o < 64; o <<= 1) v += __shfl_xor(v, o);
    return v;
}
__device__ __forceinline__ float wave_max(float v) {
#pragma unroll
    for (int o = 1; o < 64; o <<= 1) v = fmaxf(v, __shfl_xor(v, o));
    return v;
}
__device__ __forceinline__ float sigmoid_f(float x) { return 1.f / (1.f + __expf(-x)); }
__device__ __forceinline__ float silu_f(float x) { return x / (1.f + __expf(-x)); }
__device__ __forceinline__ float logsig_f(float x) { return fminf(x, 0.f) - __logf(1.f + __expf(-fabsf(x))); }
__device__ __forceinline__ bf16x8 frag(const LAS bf16* base, int ld, int row0, int k0, int lane) {
    return *(const LAS bf16x8*)(base + (row0 + (lane & 15)) * ld + k0 + (lane >> 4) * 8);
}
#define MFMA16(a, b, c) __builtin_amdgcn_mfma_f32_16x16x32_bf16((a), (b), (c), 0, 0, 0)

__device__ __forceinline__ void p0_transpose_item(const float* W, int K, int N, bf16* WT, LAS float* scr, int item, int lane) {
    const int nblk = N / 32, kb = item / nblk, nb = item % nblk, k0 = 64 * kb, n0 = 32 * nb;
#pragma unroll
    for (int i = 0; i < 32; ++i) { const int kk = 2 * i + (lane >> 5); scr[kk * 33 + (lane & 31)] = W[(size_t)(k0 + kk) * N + n0 + (lane & 31)]; }
    asm volatile("s_waitcnt lgkmcnt(0)" ::: "memory");
    const int c = lane & 7;
#pragma unroll
    for (int j = 0; j < 4; ++j) { const int n = (lane >> 3) + 8 * j; const LAS float* s = scr + (8 * c) * 33 + n;
        u32x4 o; o.x = pk2(s[0 * 33], s[1 * 33]); o.y = pk2(s[2 * 33], s[3 * 33]); o.z = pk2(s[4 * 33], s[5 * 33]); o.w = pk2(s[6 * 33], s[7 * 33]);
        *(u32x4*)(WT + (size_t)(n0 + n) * K + k0 + 8 * c) = o; }
    asm volatile("s_waitcnt lgkmcnt(0)" ::: "memory");
}

__device__ __forceinline__ void p0_phase(const Args& a, LAS unsigned char* L, int tid, int lane, int wave, int bid, int G) {
    unsigned char* ws = a.ws;
    float* MOD = (float*)(ws + WS_MOD);
    {
        LAS float* sv = (LAS float*)L;
        LAS float* red = (LAS float*)(L + 24576);
        for (int i = tid; i < 3 * 2048; i += NTHR) { const int s = i >> 11, k = i & 2047; const float c = s < 2 ? a.in[1][s * 2048 + k] : a.in[3][k]; sv[i] = silu_f(c); }
        __syncthreads();
        for (int it = bid; it < 256; it += G) {
            const int l = it >> 7, n0 = (it & 127) * 96;
            const float* W = a.in[4] + (size_t)l * 2048 * 12288 + n0;
            const int cgp = tid % 24, rg = tid / 24;
            float acc[3][4];
#pragma unroll
            for (int s = 0; s < 3; ++s)
#pragma unroll
                for (int j = 0; j < 4; ++j) acc[s][j] = 0.f;
            if (rg < 21) {
#pragma unroll 8
                for (int k = rg; k < 2048; k += 21) {
                    const f32x4 w = *(const f32x4*)(W + (size_t)k * 12288 + cgp * 4);
                    const float s0 = sv[k], s1 = sv[2048 + k], s2 = sv[4096 + k];
#pragma unroll
                    for (int j = 0; j < 4; ++j) { acc[0][j] += s0 * w[j]; acc[1][j] += s1 * w[j]; acc[2][j] += s2 * w[j]; }
                }
#pragma unroll
                for (int s = 0; s < 3; ++s)
#pragma unroll
                    for (int j = 0; j < 4; ++j) red[(rg * 3 + s) * 96 + cgp * 4 + j] = acc[s][j];
            }
            __syncthreads();
            if (tid < 288) { const int s = tid / 96, ci = tid % 96; float t = 0.f;
                for (int r2 = 0; r2 < 21; ++r2) t += red[(r2 * 3 + s) * 96 + ci];
                MOD[(size_t)(l * 3 + s) * 12288 + n0 + ci] = t + a.in[5][l * 12288 + n0 + ci]; }
            __syncthreads();
        }
    }
    if (bid == 0) {
        for (int u = tid; u < 1024; u += NTHR) { const int pos = u >> 4, i = u & 15;
            const float inv = (float)exp2(-(double)i * (13.287712379549449 / 16.0));
            const double ang = (double)pos * (double)inv;
            const double kq = rint(ang * 0.15915494309189535);
            const float rr = (float)(ang - kq * 6.283185307179586);
            f32x2 cs; cs.x = cosf(rr); cs.y = sinf(rr);
            ((f32x2*)(ws + WS_ROPE))[u] = cs; }
    }
    {
        LAS float* scr = (LAS float*)(L + wave * 16384);
        const int gw = bid * 8 + wave, NGW = G * 8;
        constexpr int I_IN = 32 * 225, I_OUT = 32 * 64, I_1 = 32 * 256, I_2 = 128 * 64, I_L = I_IN + I_OUT + I_1 + I_2;
        for (int it = gw; it < 2 * I_L; it += NGW) {
            const int l = it / I_L; int r = it % I_L;
            if (r < I_IN) { p0_transpose_item(a.in[7] + (size_t)l * DM * INC, DM, INC, (bf16*)(ws + WS_WIN + l * SZ_WIN), scr, r, lane); continue; } r -= I_IN;
            if (r < I_OUT) { p0_transpose_item(a.in[16] + (size_t)l * DM * DM, DM, DM, (bf16*)(ws + WS_WOUT + l * SZ_WOUT), scr, r, lane); continue; } r -= I_OUT;
            if (r < I_1) { p0_transpose_item(a.in[18] + (size_t)l * DM * DFF, DM, DFF, (bf16*)(ws + WS_W1 + l * SZ_W1), scr, r, lane); continue; } r -= I_1;
            p0_transpose_item(a.in[19] + (size_t)l * DFF * DM, DFF, DM, (bf16*)(ws + WS_W2 + l * SZ_W2), scr, r, lane);
        }
    }
}

template <int LT, int CT>
__device__ __forceinline__ void norm_load_row(const void* xlat, const void* xctx, int row, int lane, f32x4* v) {
    const bool isl = row < NLAT;
#pragma unroll
    for (int j = 0; j < 8; ++j) { const int c4 = lane + 64 * j;
        if (isl) { if (LT == 0) v[j] = ((const f32x4*)((const float*)xlat + (size_t)row * DM))[c4];
                   else { const u32x2 w = ((const u32x2*)((const bf16*)xlat + (size_t)row * DM))[c4]; v[j] = (f32x4){bf2f(w.x & 0xffffu), bf2f(w.x >> 16), bf2f(w.y & 0xffffu), bf2f(w.y >> 16)}; } }
        else { if (CT == 0) v[j] = ((const f32x4*)((const float*)xctx + (size_t)(row - NLAT) * DM))[c4];
               else { const u32x2 w = ((const u32x2*)((const bf16*)xctx + (size_t)(row - NLAT) * DM))[c4]; v[j] = (f32x4){bf2f(w.x & 0xffffu), bf2f(w.x >> 16), bf2f(w.y & 0xffffu), bf2f(w.y >> 16)}; } } }
}
template <int LT, int CT>
__device__ __forceinline__ void norm_phase(const void* xlat, const void* xctx, int nrows, const float* g, const float* modl, int sh_off, int sc_off, bf16* H, int lane, int gw, int NGW,
                                           const float* part = nullptr, const float* pgate = nullptr, bf16* xfin = nullptr) {
    f32x4 v[8], vn[8];
    if (gw < nrows) norm_load_row<LT, CT>(xlat, xctx, gw, lane, v);
    for (int row = gw; row < nrows; row += NGW) {
        if (row + NGW < nrows) norm_load_row<LT, CT>(xlat, xctx, row + NGW, lane, vn);
        const bool isl = row < NLAT;
        const int sg = isl ? (row >> 12) : 2;
        const float* sh = modl + sg * 12288 + sh_off; const float* sc = modl + sg * 12288 + sc_off;
        float ss = 0.f;
#pragma unroll
        for (int j = 0; j < 8; ++j) { const int c4 = lane + 64 * j;
            if (part != nullptr && !isl) {
                const size_t po = (size_t)(row - NLAT) * DM + c4 * 4;
                const f32x4 p0 = *(const f32x4*)(part + po), p1 = *(const f32x4*)(part + po + (size_t)512 * DM), p2 = *(const f32x4*)(part + po + (size_t)1024 * DM), p3 = *(const f32x4*)(part + po + (size_t)1536 * DM);
                v[j] = v[j] + ((const f32x4*)pgate)[c4] * ((p0 + p1) + (p2 + p3));
                u32x2 w; w.x = pk2(v[j].x, v[j].y); w.y = pk2(v[j].z, v[j].w); *(u32x2*)(xfin + po) = w; }
            ss += (v[j].x * v[j].x + v[j].y * v[j].y) + (v[j].z * v[j].z + v[j].w * v[j].w); }
        const float rstd = rsqrtf(wave_sum(ss) * (1.f / DM) + 1e-6f);
        u32x2* o8 = (u32x2*)(H + (size_t)row * DM);
#pragma unroll
        for (int j = 0; j < 8; ++j) { const int c4 = lane + 64 * j; const f32x4 g4 = ((const f32x4*)g)[c4], s4 = ((const f32x4*)sc)[c4], h4 = ((const f32x4*)sh)[c4];
            const f32x4 o = v[j] * rstd * g4 * (s4 + 1.f) + h4;
            u32x2 w; w.x = pk2(o.x, o.y); w.y = pk2(o.z, o.w); o8[c4] = w; }
#pragma unroll
        for (int j = 0; j < 8; ++j) v[j] = vn[j];
    }
}

typedef short s16x4 __attribute__((ext_vector_type(4)));
__device__ __forceinline__ bf16x8 frag_tr(const LAS bf16* base, int ld, int k0, int n0, int lane) {
    const int i = lane & 15;
    const LAS bf16* p = base + (k0 + (lane >> 4) * 8 + (i >> 2)) * ld + n0 + 4 * (i & 3);
    const s16x4 lo = __builtin_amdgcn_ds_read_tr16_b64_v4i16((LAS s16x4*)p);
    const s16x4 hi = __builtin_amdgcn_ds_read_tr16_b64_v4i16((LAS s16x4*)(p + 4 * ld));
    return (bf16x8){lo[0], lo[1], lo[2], lo[3], hi[0], hi[1], hi[2], hi[3]};
}
__device__ __forceinline__ float bfe(const u32x4& w, int e) { const unsigned x = w[e >> 1]; return __builtin_bit_cast(float, (e & 1) ? (x & 0xffff0000u) : (x << 16)); }
__device__ __forceinline__ unsigned cvtpk(float lo, float hi) { unsigned r; asm volatile("s_nop 1\n\tv_cvt_pk_bf16_f32 %0, %1, %2" : "=v"(r) : "v"(lo), "v"(hi)); return r; }
__device__ __forceinline__ u32x4 pack8(const float* v) { u32x4 w; w.x = cvtpk(v[0], v[1]); w.y = cvtpk(v[2], v[3]); w.z = cvtpk(v[4], v[5]); w.w = cvtpk(v[6], v[7]); return w; }

__device__ __forceinline__ void qknorm_pass(const Args& a, int l, bf16* P, int lane, int gw, int NGW) {
    const int sub = lane >> 4, li = lane & 15;
    const float* qn = a.in[13] + l * 128 + li * 8; const float* kn = a.in[14] + l * 128 + li * 8;
    float wq[8], wk[8];
#pragma unroll
    for (int e = 0; e < 8; ++e) { wq[e] = qn[e] * 0.08838834764831845f; wk[e] = kn[e]; }
#pragma unroll 2
    for (int u = gw * 4 + sub; u < MTOK * 16; u += NGW * 4) { const int row = u >> 4, hq = u & 15, isk = hq >> 3, h = hq & 7;
        bf16* p = P + (size_t)row * LDP + (isk ? C_NK : C_NQ) + h * 128 + li * 8;
        const u32x4 w = *(const u32x4*)p;
        float x[8], ss = 0.f;
#pragma unroll
        for (int e = 0; e < 8; ++e) { x[e] = bfe(w, e); ss += x[e] * x[e]; }
        ss += __shfl_xor(ss, 1); ss += __shfl_xor(ss, 2); ss += __shfl_xor(ss, 4); ss += __shfl_xor(ss, 8);
        const float rstd = rsqrtf(ss * (1.f / 128.f) + 1e-6f);
#pragma unroll
        for (int e = 0; e < 8; ++e) x[e] = x[e] * rstd * (isk ? wk[e] : wq[e]);
        *(u32x4*)p = pack8(x); }
}

__device__ __forceinline__ u32x4 norm8(const u32x4& w, const float* wt) {
    float x[8], ss = 0.f;
#pragma unroll
    for (int e = 0; e < 8; ++e) { x[e] = bfe(w, e); ss += x[e] * x[e]; }
    ss += __shfl_xor(ss, 1); ss += __shfl_xor(ss, 2); ss += __shfl_xor(ss, 4); ss += __shfl_xor(ss, 8);
    const float rstd = rsqrtf(ss * (1.f / 128.f) + 1e-6f);
#pragma unroll
    for (int e = 0; e < 8; ++e) x[e] = x[e] * rstd * wt[e];
    return pack8(x);
}
__device__ __forceinline__ void na_band(const Args& a, int l, const bf16* P, bf16* Y, int b, int h, int rbase, int nwin, LAS unsigned char* L, int tid, int lane, int wave) {
    asm volatile("" : "+v"(tid), "+v"(lane), "+s"(wave));
    LAS bf16* QN = (LAS bf16*)L;
    LAS bf16* KB = (LAS bf16*)(L + 69632);
    LAS bf16* VB = KB + 8704;
    LAS bf16* PB = (LAS bf16*)(L + 104448);
    LAS float* LS = (LAS float*)(L + 141312);
    LAS float* RB = (LAS float*)(L + 143360);
    LAS float* MISC = (LAS float*)(L + 145408);
    const float* rpb = a.in[15] + (size_t)(l * 8 + h) * 465;
    {
        const float rv = tid < 465 ? rpb[tid] : 0.f, qv = tid < 128 ? a.in[13][l * 128 + tid] : 0.f, kv = tid < 128 ? a.in[14][l * 128 + tid] : 0.f;
        if (tid < 465) RB[tid] = rv;
        const float m3 = wave_max(fabsf(rv)), m1 = wave_max(fabsf(qv)), m2 = wave_max(fabsf(kv));
        if (lane == 0) { MISC[1 + wave] = m3; MISC[9 + wave] = m1; MISC[17 + wave] = m2; }
    }
    const int uj = tid >> 4, uc = (tid & 15) * 8;
    const bf16* Ph = P + h * 128 + uc;
    float wq[8], wk[8];
#pragma unroll
    for (int e = 0; e < 8; ++e) { wq[e] = a.in[13][l * 128 + uc + e] * 0.08838834764831845f; wk[e] = a.in[14][l * 128 + uc + e]; }
    const int qrow0 = nwin ? b * SEQ + rbase * 64 : NLAT + b * CTX;
#pragma unroll
    for (int qb = 0; qb < 4; ++qb)
#pragma unroll
        for (int t = 0; t < 2; ++t) *(LAS u32x4*)(QN + qb * 8704 + (uj + 32 * t) * 136 + uc) = norm8(*(const u32x4*)(Ph + (size_t)(qrow0 + qb * 64 + uj + 32 * t) * LDP + C_NQ), wq);
    const int rlo = rbase - 4 < 0 ? 0 : (rbase - 4 > 56 ? 56 : rbase - 4), rhi3 = rbase - 1 < 0 ? 0 : (rbase - 1 > 56 ? 56 : rbase - 1);
    const int ntw = nwin ? (rhi3 + 8 - rlo) : 0, nt = ntw + 4;
    u32x4 rk[2], rv[2];
#define NA_LOADT(ti_) do { const int kr_ = (ti_) < ntw ? b * SEQ + (rlo + (ti_)) * 64 : NLAT + b * CTX + ((ti_) - ntw) * 64; \
        _Pragma("unroll") for (int t = 0; t < 2; ++t) { const bf16* pp_ = Ph + (size_t)(kr_ + uj + 32 * t) * LDP; rk[t] = *(const u32x4*)(pp_ + C_NK); rv[t] = *(const u32x4*)(pp_ + C_NV); } } while (0)
    NA_LOADT(0);
    const int qt = wave & 3, wg2 = wave >> 2, quad = lane >> 4, l15 = lane & 15;
    f32x4 o[4][4]; float lsum[4];
#pragma unroll
    for (int qb = 0; qb < 4; ++qb) { lsum[qb] = 0.f;
#pragma unroll
        for (int t = 0; t < 4; ++t) o[qb][t] = (f32x4){0.f, 0.f, 0.f, 0.f}; }
    const int qq = qt * 16 + l15, csq = qq - 8 < 0 ? 0 : (qq - 8 > 48 ? 48 : qq - 8);
    unsigned wmask = 0u;
#pragma unroll
    for (int t2 = 0; t2 < 2; ++t2)
#pragma unroll
        for (int jj = 0; jj < 4; ++jj) { const int kc = (wg2 * 2 + t2) * 16 + quad * 4 + jj; if (kc >= csq && kc < csq + 16) wmask |= 1u << (t2 * 4 + jj); }
    const int dcb = wg2 * 32 + quad * 4 - qq + 15;
    float shift = 0.f;
#pragma unroll 1
    for (int ti = 0; ti < nt; ++ti) {
        __syncthreads();
#pragma unroll
        for (int t = 0; t < 2; ++t) { *(LAS u32x4*)(KB + (uj + 32 * t) * 136 + uc) = norm8(rk[t], wk); *(LAS u32x4*)(VB + (uj + 32 * t) * 136 + uc) = rv[t]; }
        if (ti + 1 < nt) NA_LOADT(ti + 1);
        __syncthreads();
        { float m3 = 0.f, m1 = 0.f, m2 = 0.f;
#pragma unroll
          for (int w8 = 0; w8 < 8; ++w8) { m3 = fmaxf(m3, MISC[1 + w8]); m1 = fmaxf(m1, MISC[9 + w8]); m2 = fmaxf(m2, MISC[17 + w8]); }
          shift = 11.313708499f * m1 * m2 + m3; }
        const int kr = rlo + ti;
        const bool win = ti < ntw;
        const unsigned msk = win ? wmask : 0xffu;
        {
            bf16x8 kf[2][4];
#pragma unroll
            for (int t2 = 0; t2 < 2; ++t2)
#pragma unroll
                for (int ks = 0; ks < 4; ++ks) kf[t2][ks] = frag(KB, 136, (wg2 * 2 + t2) * 16, ks * 32, lane);
#pragma unroll
            for (int qb = 0; qb < 4; ++qb) {
                const int rq = rbase + qb, r0q = rq - 4 < 0 ? 0 : (rq - 4 > 56 ? 56 : rq - 4);
                const bool use = !win || (kr >= r0q && kr < r0q + 8);
                if (use) {
                    const LAS float* rbr = RB + (win ? (kr - rq + 7) * 31 : 0);
                    f32x4 sT[2];
                    sT[0] = (f32x4){0.f, 0.f, 0.f, 0.f}; sT[1] = (f32x4){0.f, 0.f, 0.f, 0.f};
#pragma unroll
                    for (int ks = 0; ks < 4; ++ks) { const bf16x8 qf = frag(QN + qb * 8704, 136, qt * 16, ks * 32, lane);
                        sT[0] = MFMA16(kf[0][ks], qf, sT[0]); sT[1] = MFMA16(kf[1][ks], qf, sT[1]); }
#pragma unroll
                    for (int t2 = 0; t2 < 2; ++t2) { const int ktile = wg2 * 2 + t2;
                        float pv[4];
#pragma unroll
                        for (int jj = 0; jj < 4; ++jj) { const bool valid = (msk >> (t2 * 4 + jj)) & 1u;
                            int bi = dcb + 16 * t2 + jj; bi = bi < 0 ? 0 : (bi > 30 ? 30 : bi);
                            const float bias = win ? rbr[bi] : 0.f;
                            pv[jj] = valid ? __expf(sT[t2][jj] + bias - shift) : 0.f; lsum[qb] += pv[jj]; }
                        u32x2 w; w.x = cvtpk(pv[0], pv[1]); w.y = cvtpk(pv[2], pv[3]);
                        *(LAS u32x2*)(PB + qb * 4608 + qq * 72 + ktile * 16 + quad * 4) = w; }
                }
            }
        }
        __syncthreads();
        {
            __builtin_amdgcn_s_setprio(1);
            bf16x8 vf[2][4];
#pragma unroll
            for (int ks = 0; ks < 2; ++ks)
#pragma unroll
                for (int t = 0; t < 4; ++t) vf[ks][t] = frag_tr(VB, 136, ks * 32, (wg2 * 4 + t) * 16, lane);
#pragma unroll
            for (int qb = 0; qb < 4; ++qb) {
                const int rq = rbase + qb, r0q = rq - 4 < 0 ? 0 : (rq - 4 > 56 ? 56 : rq - 4);
                const bool use = !win || (kr >= r0q && kr < r0q + 8);
                if (use) {
#pragma unroll
                    for (int ks = 0; ks < 2; ++ks) { const bf16x8 af = frag(PB + qb * 4608, 72, qt * 16, ks * 32, lane);
#pragma unroll
                        for (int t = 0; t < 4; ++t) o[qb][t] = MFMA16(af, vf[ks][t], o[qb][t]); }
                }
            }
            __builtin_amdgcn_s_setprio(0);
        }
    }
#undef NA_LOADT
#pragma unroll
    for (int qb = 0; qb < 4; ++qb) { float v = lsum[qb]; v += __shfl_xor(v, 16); v += __shfl_xor(v, 32);
        if (quad == 0) LS[qb * 128 + wg2 * 64 + qq] = v; }
    __syncthreads();
#pragma unroll
    for (int qb = 0; qb < 4; ++qb)
#pragma unroll
        for (int jj = 0; jj < 4; ++jj) { const int q = qt * 16 + quad * 4 + jj; const float inv = 1.f / (LS[qb * 128 + q] + LS[qb * 128 + 64 + q]);
            bf16* yr = Y + (size_t)(qrow0 + qb * 64 + q) * DM + 1024 + h * 128 + wg2 * 64 + l15;
#pragma unroll
            for (int t = 0; t < 4; ++t) yr[t * 16] = (bf16)f2bf(o[qb][t][jj] * inv); }
    __syncthreads();
}

template <int MX> __device__ __forceinline__ void load_unit(const Args& a, const bf16* prow, int h, int dg, int seg, int c, int jtok, int dir, bool need_q,
                                                              const float* lbv, const LAS float* W2L, float* q, float* k, float* g) {
    if (MX == 0) {
        const u32x4 a0 = *(const u32x4*)(prow + C_GA + dir * 16), a1 = *(const u32x4*)(prow + C_GA + dir * 16 + 8);
        float s[8];
#pragma unroll
        for (int e = 0; e < 8; ++e) s[e] = W2L[1024 + dg * 8 + e];
#pragma unroll
        for (int r = 0; r < 16; ++r) { const float al = r < 8 ? bfe(a0, r) : bfe(a1, r - 8);
            const f32x4 w0 = *(const LAS f32x4*)(W2L + r * 64 + dg * 8), w1 = *(const LAS f32x4*)(W2L + r * 64 + dg * 8 + 4);
#pragma unroll
            for (int e = 0; e < 4; ++e) { s[e] += al * w0[e]; s[4 + e] += al * w1[e]; }
            if ((r & 3) == 3) __builtin_amdgcn_sched_barrier(0); }
#pragma unroll
        for (int e = 0; e < 8; ++e) g[e] = logsig_f(s[e]) * (1.f / 16.f);
        const int odd = (dg >> 1) & 1, hf = dg >> 2, i0 = (dg & 1) * 8;
        float cs[8], sn[8];
        if (seg) { const f32x4* rp = (const f32x4*)((const f32x2*)(a.ws + WS_ROPE) + (hf ? jtok : c) * 16 + i0);
#pragma unroll
            for (int e2 = 0; e2 < 4; ++e2) { const f32x4 t = rp[e2]; cs[2 * e2] = t.x; sn[2 * e2] = t.y; cs[2 * e2 + 1] = t.z; sn[2 * e2 + 1] = t.w; } }
        else {
#pragma unroll
            for (int e = 0; e < 8; ++e) { cs[e] = 1.f; sn[e] = 0.f; } }
        { const u32x4 ow = *(const u32x4*)(prow + C_GK + h * 64 + dg * 8), pw = *(const u32x4*)(prow + C_GK + h * 64 + (dg ^ 2) * 8);
#pragma unroll
            for (int e = 0; e < 8; ++e) { const float own = bfe(ow, e), par = bfe(pw, e); k[e] = odd ? (par * sn[e] + own * cs[e]) : (own * cs[e] - par * sn[e]); } }
        if (need_q) { const u32x4 ow = *(const u32x4*)(prow + C_GQ + h * 64 + dg * 8), pw = *(const u32x4*)(prow + C_GQ + h * 64 + (dg ^ 2) * 8);
#pragma unroll
            for (int e = 0; e < 8; ++e) { const float own = bfe(ow, e) * 0.125f, par = bfe(pw, e) * 0.125f; q[e] = odd ? (par * sn[e] + own * cs[e]) : (own * cs[e] - par * sn[e]); } }
    } else {
        const u32x4 fw = *(const u32x4*)(prow + C_HF + dir * 512 + h * 128 + dg * 8);
#pragma unroll
        for (int e = 0; e < 8; ++e) { const float ex = __expf(-bfe(fw, e)), sg = 1.f / (1.f + ex), lb = lbv[e];
            g[e] = __logf(lb + (1.f - lb) * sg); k[e] = (1.f - lb) * (ex * sg); }
        if (need_q) { const u32x4 qw = *(const u32x4*)(prow + C_HQ + h * 128 + dg * 8);
#pragma unroll
            for (int e = 0; e < 8; ++e) q[e] = silu_f(bfe(qw, e)); }
    }
}
__device__ __forceinline__ void load_lb(const Args& a, int l, int dir, int h, int dg, float* lbv) {
    const float* hlb = a.in[11];
#pragma unroll
    for (int e = 0; e < 8; ++e) { float lb = 0.f;
        if (l == 1) { const float b0 = hlb[dir * 512 + h * 128 + dg * 8 + e], b1 = hlb[(2 + dir) * 512 + h * 128 + dg * 8 + e]; lb = 1.f / (1.f + __expf(b0 - b1)); }
        lbv[e] = lb; }
}
__device__ __forceinline__ void stage_w2(const Args& a, int l, int dir, int h, LAS float* W2L, int tid) {
    const float* w2 = a.in[8] + (size_t)((l * 2 + dir) * 16) * 256 + h * 64;
    const float* ba = a.in[9] + (l * 2 + dir) * 256 + h * 64;
    const float v0 = w2[(tid >> 6) * 256 + (tid & 63)], v1 = w2[((tid + 512) >> 6) * 256 + (tid & 63)], v2 = tid < 64 ? ba[tid] : 0.f;
    W2L[tid] = v0; W2L[tid + 512] = v1; if (tid < 64) W2L[1024 + tid] = v2;
}
template <int DK> __device__ __forceinline__ void cumsum_p(LAS float* CF, LAS float* SG, int tid) {
    constexpr int CS = DK + 4, NSEG = NTHR / DK, SL = 64 / NSEG;
    const int d = tid % DK, sg = tid / DK;
    float run = 0.f;
#pragma unroll 4
    for (int p = sg * SL; p < sg * SL + SL; ++p) { run += CF[p * CS + d]; CF[p * CS + d] = run; }
    SG[sg * DK + d] = run;
    __syncthreads();
    float off = 0.f;
    for (int s2 = 0; s2 < sg; ++s2) off += SG[s2 * DK + d];
#pragma unroll 4
    for (int p = sg * SL; p < sg * SL + SL; ++p) CF[p * CS + d] += off;
    __syncthreads();
}
__device__ __forceinline__ int scan_chunk(int seg, int c, int dir) { return seg ? 4 + (dir ? 63 - c : c) : (dir ? 3 - c : c); }

template <int MX> __device__ __forceinline__ void s1_item(const Args& a, int l, const bf16* P, int bh, int seg, int c, int dir, LAS unsigned char* L, int tid, int lane, int wave) {
    asm volatile("" : "+v"(tid), "+v"(lane), "+s"(wave));
    constexpr int DK = MX ? 128 : 64, DB = DK + 8, CS = DK + 4, NDG = DK / 8, UPT = (64 * NDG) / NTHR, NT = DK / 16;
    LAS float* CF = (LAS float*)L;
    LAS bf16* KB = (LAS bf16*)(L + 33792);
    LAS bf16* VB = (LAS bf16*)(L + 51200);
    LAS float* SG = (LAS float*)(L + 68608);
    LAS float* W2L = (LAS float*)(L + 70656);
    const int b = bh >> 2, h = bh & 3;
    const int row0 = seg ? b * SEQ + c * 64 : NLAT + b * CTX + c * 64;
    const int vcol = (MX ? C_HI : C_GV) + h * 128;
    if (MX == 0) stage_w2(a, l, dir, h, W2L, tid);
#pragma unroll
    for (int t = 0; t < 2; ++t) { const int u = tid + NTHR * t, p = u >> 4, ch = u & 15, j = dir ? 63 - p : p;
        *(LAS u32x4*)(VB + p * 136 + ch * 8) = *(const u32x4*)(P + (size_t)(row0 + j) * LDP + vcol + ch * 8); }
    __syncthreads();
    float kv[UPT][8];
    {
        float lbv[8];
        if (MX == 1) load_lb(a, l, dir, h, tid % NDG, lbv);
#pragma unroll
        for (int t = 0; t < UPT; ++t) { const int u = tid + NTHR * t, p = u / NDG, dg = u % NDG, j = dir ? 63 - p : p;
            float g[8], qd[8];
            load_unit<MX>(a, P + (size_t)(row0 + j) * LDP, h, dg, seg, c, j, dir, false, lbv, W2L, qd, kv[t], g);
            *(LAS f32x4*)(CF + p * CS + dg * 8) = (f32x4){g[0], g[1], g[2], g[3]}; *(LAS f32x4*)(CF + p * CS + dg * 8 + 4) = (f32x4){g[4], g[5], g[6], g[7]}; }
    }
    __syncthreads();
    cumsum_p<DK>(CF, SG, tid);
#pragma unroll
    for (int t = 0; t < UPT; ++t) { const int u = tid + NTHR * t, p = u / NDG, dg = u % NDG;
        float o[8];
#pragma unroll
        for (int e = 0; e < 8; ++e) o[e] = kv[t][e] * __expf(CF[63 * CS + dg * 8 + e] - CF[p * CS + dg * 8 + e]);
        *(LAS u32x4*)(KB + p * DB + dg * 8) = pack8(o); }
    const int sc = scan_chunk(seg, c, dir);
    const size_t sidx = (size_t)((bh * 2 + dir) * NSC + sc);
    float* ST = (float*)(a.ws + (MX ? WS_STH : WS_STG)) + sidx * (DK * 128);
    float* DC = (float*)(a.ws + (MX ? WS_DCH : WS_DCG)) + sidx * DK;
    if (tid < DK) DC[tid] = __expf(CF[63 * CS + tid]);
    __syncthreads();
    const int dt = wave % NT, vb = (wave / NT) * NT, quad = lane >> 4, l15 = lane & 15;
    f32x4 acc[NT];
#pragma unroll
    for (int t = 0; t < NT; ++t) acc[t] = (f32x4){0.f, 0.f, 0.f, 0.f};
#pragma unroll
    for (int ks = 0; ks < 2; ++ks) { const bf16x8 af = frag_tr(KB, DB, ks * 32, dt * 16, lane);
#pragma unroll
        for (int t = 0; t < NT; ++t) acc[t] = MFMA16(af, frag_tr(VB, 136, ks * 32, (vb + t) * 16, lane), acc[t]); }
#pragma unroll
    for (int t = 0; t < NT; ++t)
#pragma unroll
        for (int jj = 0; jj < 4; ++jj) ST[(dt * 16 + quad * 4 + jj) * 128 + (vb + t) * 16 + l15] = acc[t][jj];
    __syncthreads();
}

template <int DK> __device__ __forceinline__ void cumsum_p2(LAS float* CF0, LAS float* CF1, LAS float* SG, int tid) {
    constexpr int CS = DK + 4, NSEG = NTHR / DK, SL = 64 / NSEG;
    const int d = tid % DK, sg = tid / DK;
    float run0 = 0.f, run1 = 0.f;
#pragma unroll 4
    for (int p = sg * SL; p < sg * SL + SL; ++p) { run0 += CF0[p * CS + d]; CF0[p * CS + d] = run0; run1 += CF1[p * CS + d]; CF1[p * CS + d] = run1; }
    SG[sg * DK + d] = run0; SG[512 + sg * DK + d] = run1;
    __syncthreads();
    float off0 = 0.f, off1 = 0.f;
    for (int s2 = 0; s2 < sg; ++s2) { off0 += SG[s2 * DK + d]; off1 += SG[512 + s2 * DK + d]; }
#pragma unroll 4
    for (int p = sg * SL; p < sg * SL + SL; ++p) { CF0[p * CS + d] += off0; CF1[p * CS + d] += off1; }
    __syncthreads();
}
template <int MX> __device__ __forceinline__ void s1_item2(const Args& a, int l, const bf16* P, int bh, int seg, int c, LAS unsigned char* L, int tid, int lane, int wave) {
    asm volatile("" : "+v"(tid), "+v"(lane), "+s"(wave));
    constexpr int DK = MX ? 128 : 64, DB = DK + 8, CS = DK + 4, NDG = DK / 8, UPT = (64 * NDG) / NTHR, NT = DK / 16;
    LAS float* CF0 = (LAS float*)L;
    LAS float* CF1 = (LAS float*)(L + 33792);
    LAS bf16* KB0 = (LAS bf16*)(L + 67584);
    LAS bf16* KB1 = (LAS bf16*)(L + 84992);
    LAS bf16* VB = (LAS bf16*)(L + 102400);
    LAS float* SG = (LAS float*)(L + 119808);
    LAS float* W2L = (LAS float*)(L + 123904);
    const int b = bh >> 2, h = bh & 3;
    const int row0 = seg ? b * SEQ + c * 64 : NLAT + b * CTX + c * 64;
    const int vcol = (MX ? C_HI : C_GV) + h * 128;
    if (MX == 0) { stage_w2(a, l, 0, h, W2L, tid); stage_w2(a, l, 1, h, W2L + 1088, tid); }
#pragma unroll
    for (int t = 0; t < 2; ++t) { const int u = tid + NTHR * t, j = u >> 4, ch = u & 15;
        *(LAS u32x4*)(VB + j * 136 + ch * 8) = *(const u32x4*)(P + (size_t)(row0 + j) * LDP + vcol + ch * 8); }
    __syncthreads();
    float kv0[UPT][8], kv1[UPT][8];
    {
        float lbv0[8], lbv1[8];
        if (MX == 1) { load_lb(a, l, 0, h, tid % NDG, lbv0); load_lb(a, l, 1, h, tid % NDG, lbv1); }
#pragma unroll
        for (int t = 0; t < UPT; ++t) { const int u = tid + NTHR * t, j = u / NDG, dg = u % NDG;
            float g0[8], g1[8], qd[8];
            load_unit<MX>(a, P + (size_t)(row0 + j) * LDP, h, dg, seg, c, j, 0, false, lbv0, W2L, qd, kv0[t], g0);
            *(LAS f32x4*)(CF0 + j * CS + dg * 8) = (f32x4){g0[0], g0[1], g0[2], g0[3]}; *(LAS f32x4*)(CF0 + j * CS + dg * 8 + 4) = (f32x4){g0[4], g0[5], g0[6], g0[7]};
            __builtin_amdgcn_sched_barrier(0);
            load_unit<MX>(a, P + (size_t)(row0 + j) * LDP, h, dg, seg, c, j, 1, false, lbv1, W2L + 1088, qd, kv1[t], g1);
            *(LAS f32x4*)(CF1 + (63 - j) * CS + dg * 8) = (f32x4){g1[0], g1[1], g1[2], g1[3]}; *(LAS f32x4*)(CF1 + (63 - j) * CS + dg * 8 + 4) = (f32x4){g1[4], g1[5], g1[6], g1[7]};
            __builtin_amdgcn_sched_barrier(0); }
    }
    __syncthreads();
    cumsum_p2<DK>(CF0, CF1, SG, tid);
#pragma unroll
    for (int t = 0; t < UPT; ++t) { const int u = tid + NTHR * t, j = u / NDG, dg = u % NDG;
        float o[8];
#pragma unroll
        for (int e = 0; e < 8; ++e) o[e] = kv0[t][e] * __expf(CF0[63 * CS + dg * 8 + e] - CF0[j * CS + dg * 8 + e]);
        *(LAS u32x4*)(KB0 + j * DB + dg * 8) = pack8(o);
#pragma unroll
        for (int e = 0; e < 8; ++e) o[e] = kv1[t][e] * __expf(CF1[63 * CS + dg * 8 + e] - CF1[(63 - j) * CS + dg * 8 + e]);
        *(LAS u32x4*)(KB1 + j * DB + dg * 8) = pack8(o); }
    const size_t sidx0 = (size_t)((bh * 2 + 0) * NSC + scan_chunk(seg, c, 0)), sidx1 = (size_t)((bh * 2 + 1) * NSC + scan_chunk(seg, c, 1));
    bf16* STb = (bf16*)(a.ws + (MX ? WS_STH : WS_STG)); float* DCb = (float*)(a.ws + (MX ? WS_DCH : WS_DCG));
    if (tid < DK) { DCb[sidx0 * DK + tid] = __expf(CF0[63 * CS + tid]); DCb[sidx1 * DK + tid] = __expf(CF1[63 * CS + tid]); }
    __syncthreads();
    const int dt = wave % NT, vb = (wave / NT) * NT;
#pragma unroll 1
    for (int dir = 0; dir < 2; ++dir) {
        int lane2 = lane; asm volatile("" : "+v"(lane2));
        const int quad = lane2 >> 4, l15 = lane2 & 15;
        const LAS bf16* KB = dir ? KB1 : KB0; bf16* ST = STb + (dir ? sidx1 : sidx0) * (DK * 128);
        f32x4 acc[NT];
#pragma unroll
        for (int t = 0; t < NT; ++t) acc[t] = (f32x4){0.f, 0.f, 0.f, 0.f};
#pragma unroll
        for (int ks = 0; ks < 2; ++ks) { const bf16x8 kfr = frag_tr(KB, DB, ks * 32, dt * 16, lane2);
#pragma unroll
            for (int t = 0; t < NT; ++t) acc[t] = MFMA16(frag_tr(VB, 136, ks * 32, (vb + t) * 16, lane2), kfr, acc[t]); }
#pragma unroll
        for (int t = 0; t < NT; ++t) { u32x2 w; w.x = pk2(acc[t][0], acc[t][1]); w.y = pk2(acc[t][2], acc[t][3]);
            *(u32x2*)(ST + (dt * 16 + l15) * 128 + (vb + t) * 16 + quad * 4) = w; }
    }
    __syncthreads();
}

__device__ __forceinline__ void s2_phase(const Args& a, int gtid, int nthreads) {
    for (int e4 = gtid; e4 < 98304; e4 += nthreads) {
        const bf16* st; bf16* sb; const float* dc; int ss, sd;
        if (e4 < 32768) { const int sq = e4 >> 11, rem = (e4 & 2047) * 4; st = (const bf16*)(a.ws + WS_STG) + (size_t)sq * NSC * 8192 + rem; sb = (bf16*)(a.ws + WS_SBG) + (size_t)sq * NSC * 8192 + rem;
            dc = (const float*)(a.ws + WS_DCG) + sq * NSC * 64 + (rem >> 7); ss = 8192; sd = 64; }
        else { const int e2 = e4 - 32768, sq = e2 >> 12, rem = (e2 & 4095) * 4; st = (const bf16*)(a.ws + WS_STH) + (size_t)sq * NSC * 16384 + rem; sb = (bf16*)(a.ws + WS_SBH) + (size_t)sq * NSC * 16384 + rem;
            dc = (const float*)(a.ws + WS_DCH) + sq * NSC * 128 + (rem >> 7); ss = 16384; sd = 128; }
        f32x4 S = (f32x4){0.f, 0.f, 0.f, 0.f};
#pragma unroll 17
        for (int sc = 0; sc < NSC; ++sc) { const u32x2 lw = *(const u32x2*)(st + (size_t)sc * ss); const float dv = dc[sc * sd];
            const f32x4 Lv = (f32x4){bf2f(lw.x & 0xffffu), bf2f(lw.x >> 16), bf2f(lw.y & 0xffffu), bf2f(lw.y >> 16)};
            u32x2 w; w.x = pk2(S.x, S.y); w.y = pk2(S.z, S.w); *(u32x2*)(sb + (size_t)sc * ss) = w; S = S * dv + Lv; }
    }
}

template <int MX> __device__ __forceinline__ void s3_item(const Args& a, int l, const bf16* P, bf16* Y, int bh, int seg, int c, LAS unsigned char* L, int tid, int lane, int wave) {
    asm volatile("" : "+v"(tid), "+v"(lane), "+s"(wave));
    constexpr int DK = MX ? 128 : 64, DB = DK + 8, CS = DK + 4, NDG = DK / 8, UPT = (64 * NDG) / NTHR, NS0 = (DK * 16) / NTHR;
    LAS float* CF = (LAS float*)L;
    LAS bf16* QT = (LAS bf16*)(L + 33792);
    LAS bf16* KD = (LAS bf16*)(L + 51200);
    LAS bf16* KO = (LAS bf16*)(L + 68608);
    LAS bf16* S0B = (LAS bf16*)(L + 51200);
    LAS bf16* QS = (LAS bf16*)(L + 94720);
    LAS bf16* VB = (LAS bf16*)(L + 112128);
    LAS bf16* ATT = (LAS bf16*)(L + 129536);
    LAS float* SG = (LAS float*)(L + 138752);
    LAS float* W2L = (LAS float*)(L + 140800);
    LAS float* OF = (LAS float*)L;
    const int b = bh >> 2, h = bh & 3;
    const int row0 = seg ? b * SEQ + c * 64 : NLAT + b * CTX + c * 64;
    const int vcol = (MX ? C_HI : C_GV) + h * 128;
    const int it_ = wave & 3, vb = (wave >> 2) * 4, quad = lane >> 4, l15 = lane & 15;
    f32x4 acc[4];
#pragma unroll
    for (int t = 0; t < 4; ++t) acc[t] = (f32x4){0.f, 0.f, 0.f, 0.f};
#pragma unroll
    for (int t = 0; t < 2; ++t) { const int u = tid + NTHR * t, j = u >> 4, ch = u & 15;
        *(LAS u32x4*)(VB + j * 136 + ch * 8) = *(const u32x4*)(P + (size_t)(row0 + j) * LDP + vcol + ch * 8); }
#pragma unroll 1
    for (int dir = 0; dir < 2; ++dir) {
        if (MX == 0) { stage_w2(a, l, dir, h, W2L, tid); __syncthreads(); }
        float qv[UPT][8], kv[UPT][8];
        {
            float lbv[8];
            if (MX == 1) load_lb(a, l, dir, h, tid % NDG, lbv);
#pragma unroll
            for (int t = 0; t < UPT; ++t) { const int u = tid + NTHR * t, p = u / NDG, dg = u % NDG, j = dir ? 63 - p : p;
                float g[8];
                load_unit<MX>(a, P + (size_t)(row0 + j) * LDP, h, dg, seg, c, j, dir, true, lbv, W2L, qv[t], kv[t], g);
                *(LAS f32x4*)(CF + p * CS + dg * 8) = (f32x4){g[0], g[1], g[2], g[3]}; *(LAS f32x4*)(CF + p * CS + dg * 8 + 4) = (f32x4){g[4], g[5], g[6], g[7]}; }
        }
        __syncthreads();
        cumsum_p<DK>(CF, SG, tid);
#pragma unroll
        for (int t = 0; t < UPT; ++t) { const int u = tid + NTHR * t, p = u / NDG, dg = u % NDG, j = dir ? 63 - p : p, sa = p >> 4;
            float cc[8], rf[8], o[8];
            { const f32x4 c0 = *(const LAS f32x4*)(CF + p * CS + dg * 8), c1 = *(const LAS f32x4*)(CF + p * CS + dg * 8 + 4);
#pragma unroll
              for (int e = 0; e < 4; ++e) { cc[e] = c0[e]; cc[4 + e] = c1[e]; } }
            if (sa > 0) { const f32x4 r0 = *(const LAS f32x4*)(CF + (16 * sa - 1) * CS + dg * 8), r1 = *(const LAS f32x4*)(CF + (16 * sa - 1) * CS + dg * 8 + 4);
#pragma unroll
              for (int e = 0; e < 4; ++e) { rf[e] = r0[e]; rf[4 + e] = r1[e]; } }
            else {
#pragma unroll
              for (int e = 0; e < 8; ++e) rf[e] = 0.f; }
#pragma unroll
            for (int e = 0; e < 8; ++e) o[e] = qv[t][e] * __expf(cc[e] - rf[e]);
            *(LAS u32x4*)(QT + p * DB + dg * 8) = pack8(o);
#pragma unroll
            for (int e = 0; e < 8; ++e) o[e] = kv[t][e] * __expf(fminf(rf[e] - cc[e], 80.f));
            *(LAS u32x4*)(KD + p * DB + dg * 8) = pack8(o);
#pragma unroll
            for (int e = 0; e < 8; ++e) o[e] = qv[t][e] * __expf(cc[e]);
            *(LAS u32x4*)(QS + j * DB + dg * 8) = pack8(o);
            for (int a2 = sa + 1; a2 < 4; ++a2) { const f32x4 r0 = *(const LAS f32x4*)(CF + (16 * a2 - 1) * CS + dg * 8), r1 = *(const LAS f32x4*)(CF + (16 * a2 - 1) * CS + dg * 8 + 4);
#pragma unroll
                for (int e = 0; e < 4; ++e) { o[e] = kv[t][e] * __expf(r0[e] - cc[e]); o[4 + e] = kv[t][4 + e] * __expf(r1[e] - cc[4 + e]); }
                *(LAS u32x4*)(KO + ((a2 == 1 ? 0 : (a2 == 2 ? 16 : 48)) + p) * DB + dg * 8) = pack8(o); }
        }
        u32x4 s0r[NS0];
        {
            const int sc = scan_chunk(seg, c, dir);
            const bf16* SB = (const bf16*)(a.ws + (MX ? WS_SBH : WS_SBG)) + (size_t)((bh * 2 + dir) * NSC + sc) * (DK * 128);
#pragma unroll
            for (int t = 0; t < NS0; ++t) s0r[t] = *(const u32x4*)(SB + (size_t)(tid + NTHR * t) * 8);
        }
        __syncthreads();
#pragma unroll
        for (int t2 = 0; t2 < 2; ++t2) { const int s = wave * 2 + t2, sa = s >> 2, sb = s & 3;
            f32x4 sacc = (f32x4){0.f, 0.f, 0.f, 0.f};
            if (sb <= sa) {
                const LAS bf16* kb = (sa == sb) ? KD + (16 * sa) * DB : KO + ((sa == 1 ? 0 : (sa == 2 ? 16 : 48)) + 16 * sb) * DB;
#pragma unroll
                for (int ks = 0; ks < DK / 32; ++ks) sacc = MFMA16(frag(kb, DB, 0, ks * 32, lane), frag(QT, DB, 16 * sa, ks * 32, lane), sacc);
            }
            float v[4];
#pragma unroll
            for (int jj = 0; jj < 4; ++jj) v[jj] = (sb < sa || (sb == sa && quad * 4 + jj <= l15)) ? sacc[jj] : 0.f;
            const int p = 16 * sa + l15, pp0 = 16 * sb + quad * 4;
            u32x2 w;
            if (dir) { w.x = cvtpk(v[3], v[2]); w.y = cvtpk(v[1], v[0]); *(LAS u32x2*)(ATT + (63 - p) * 72 + 60 - pp0) = w; }
            else { w.x = cvtpk(v[0], v[1]); w.y = cvtpk(v[2], v[3]); *(LAS u32x2*)(ATT + p * 72 + pp0) = w; } }
        __syncthreads();
#pragma unroll
        for (int t = 0; t < NS0; ++t) { const int u = tid + NTHR * t, d = u >> 4, ch = u & 15; *(LAS u32x4*)(S0B + d * 136 + ch * 8) = s0r[t]; }
        __syncthreads();
#pragma unroll
        for (int ks = 0; ks < 2; ++ks) { const bf16x8 af = frag(ATT, 72, it_ * 16, ks * 32, lane);
#pragma unroll
            for (int t = 0; t < 4; ++t) acc[t] = MFMA16(af, frag_tr(VB, 136, ks * 32, (vb + t) * 16, lane), acc[t]); }
#pragma unroll
        for (int ks = 0; ks < DK / 32; ++ks) { const bf16x8 af = frag(QS, DB, it_ * 16, ks * 32, lane);
#pragma unroll
            for (int t = 0; t < 4; ++t) acc[t] = MFMA16(af, frag_tr(S0B, 136, ks * 32, (vb + t) * 16, lane), acc[t]); }
        __syncthreads();
    }
    const int gcol = (MX ? C_HG : C_GR) + h * 128, ycol = (MX ? 512 : 0) + h * 128;
    unsigned gwv[8];
#pragma unroll
    for (int rr = 0; rr < 8; ++rr) gwv[rr] = *(const unsigned*)(P + (size_t)(row0 + wave * 8 + rr) * LDP + gcol + lane * 2);
#pragma unroll
    for (int t = 0; t < 4; ++t)
#pragma unroll
        for (int jj = 0; jj < 4; ++jj) OF[(it_ * 16 + quad * 4 + jj) * 132 + (vb + t) * 16 + l15] = acc[t][jj];
    __syncthreads();
    const float* ng = (MX ? a.in[12] : a.in[10]) + l * 128;
    const float n0 = ng[lane * 2], n1 = ng[lane * 2 + 1];
#pragma unroll
    for (int rr = 0; rr < 8; ++rr) { const int i = wave * 8 + rr;
        const float o0 = OF[i * 132 + lane * 2], o1 = OF[i * 132 + lane * 2 + 1];
        const float rstd = rsqrtf(wave_sum(o0 * o0 + o1 * o1) * (1.f / 128.f) + 1e-6f);
        const unsigned gw = gwv[rr];
        const float y0 = o0 * rstd * n0 * silu_f(bf2f(gw & 0xffffu)), y1 = o1 * rstd * n1 * silu_f(bf2f(gw >> 16));
        *(unsigned*)(Y + (size_t)(row0 + i) * DM + ycol + lane * 2) = pk2(y0, y1); }
    __syncthreads();
}


template <int MODE> __device__ __forceinline__ void sgemm_ctx(const bf16* A, const bf16* Bt, int K, int N, int S, bf16* O, float* PART,
                                                              LAS unsigned char* L, int tid, int lane, int wave, int bid, int G) {
    const int ntn = N / 128, nitems = 4 * ntn * S, kspan = K / S, ns = kspan / 128;
    const int uj = tid >> 4, uc = (tid & 15) * 8;
    const int wm = wave & 3, wn = wave >> 2, quad = lane >> 4, l15 = lane & 15;
#pragma unroll 1
    for (int it = bid; it < nitems; it += G) {
        const int sp = it % S, r1 = it / S, tn = r1 % ntn, tm = r1 / ntn;
        const bf16* Ap = A + (size_t)(tm * 128 + uj) * K + sp * kspan + uc; const bf16* Bp = Bt + (size_t)(tn * 128 + uj) * K + sp * kspan + uc;
        u32x4 ra[4], rb[4], rc[4], rd[4];
#define SG_LOAD(ra_, rb_, st_) do { _Pragma("unroll") for (int t = 0; t < 4; ++t) { ra_[t] = *(const u32x4*)(Ap + (size_t)(32 * t) * K + (st_) * 128); rb_[t] = *(const u32x4*)(Bp + (size_t)(32 * t) * K + (st_) * 128); } } while (0)
#define SG_STORE(ra_, rb_, buf_) do { LAS bf16* An_ = (LAS bf16*)L + (buf_) * 34816; _Pragma("unroll") for (int t = 0; t < 4; ++t) { *(LAS u32x4*)(An_ + (uj + 32 * t) * 136 + uc) = ra_[t]; *(LAS u32x4*)(An_ + 17408 + (uj + 32 * t) * 136 + uc) = rb_[t]; } } while (0)
#define SG_COMPUTE(buf_) do { const LAS bf16* As = (const LAS bf16*)L + (buf_) * 34816; const LAS bf16* Bs = As + 17408; __builtin_amdgcn_s_setprio(1); \
            _Pragma("unroll") for (int ks = 0; ks < 4; ++ks) { const bf16x8 af0 = frag(As, 136, wm * 32, ks * 32, lane), af1 = frag(As, 136, wm * 32 + 16, ks * 32, lane); \
                _Pragma("unroll") for (int t = 0; t < 4; ++t) { const bf16x8 bfm = frag(Bs, 136, wn * 64 + t * 16, ks * 32, lane); \
                    acc[0][t] = MFMA16(af0, bfm, acc[0][t]); acc[1][t] = MFMA16(af1, bfm, acc[1][t]); } } __builtin_amdgcn_s_setprio(0); } while (0)
        SG_LOAD(ra, rb, 0);
        if (ns > 1) SG_LOAD(rc, rd, 1);
        SG_STORE(ra, rb, 0);
        if (ns > 2) SG_LOAD(ra, rb, 2);
        __syncthreads();
        f32x4 acc[2][4];
#pragma unroll
        for (int i = 0; i < 2; ++i)
#pragma unroll
            for (int t = 0; t < 4; ++t) acc[i][t] = (f32x4){0.f, 0.f, 0.f, 0.f};
#pragma unroll 1
        for (int s = 0; s < ns; s += 2) {
            SG_COMPUTE(0);
            if (s + 1 < ns) SG_STORE(rc, rd, 1);
            if (s + 3 < ns) SG_LOAD(rc, rd, s + 3);
            __syncthreads();
            if (s + 1 < ns) {
                SG_COMPUTE(1);
                if (s + 2 < ns) SG_STORE(ra, rb, 0);
                if (s + 4 < ns) SG_LOAD(ra, rb, s + 4);
                __syncthreads();
            }
        }
#undef SG_LOAD
#undef SG_STORE
#undef SG_COMPUTE
#pragma unroll
        for (int i = 0; i < 2; ++i)
#pragma unroll
            for (int t = 0; t < 4; ++t) { const int col = tn * 128 + wn * 64 + t * 16 + l15;
#pragma unroll
                for (int jj = 0; jj < 4; ++jj) { const int row = tm * 128 + wm * 32 + i * 16 + quad * 4 + jj;
                    if (MODE == 1) { const float v = acc[i][t][jj] > 0.f ? acc[i][t][jj] : 0.f; O[(size_t)row * N + col] = (bf16)f2bf(v * v); }
                    else PART[((size_t)sp * 512 + row) * N + col] = acc[i][t][jj]; } }
    }
}

#define XB_TMO      128
#define XB_XCNT(j)  (256  + 64 * (j))
#define XB_XSUB(j)  (1280 + 64 * (j))
#define XB_XGEN(j)  (2304 + 64 * (j))
#define XB_TOP      3328
#define XB_TOPGEN   3392
#define XCD_BAR_WORDS 3456
#define XB_SPIN_CAP (1u << 18)

__device__ __forceinline__ unsigned xb_ld(unsigned* p)              { return __hip_atomic_load(p, __ATOMIC_RELAXED, __HIP_MEMORY_SCOPE_AGENT); }
__device__ __forceinline__ unsigned xb_add(unsigned* p, unsigned v) { return __hip_atomic_fetch_add(p, v, __ATOMIC_RELAXED, __HIP_MEMORY_SCOPE_AGENT); }
__device__ __forceinline__ unsigned xb_xcc_id() { return (unsigned)__builtin_amdgcn_s_getreg((3 << 11) | 20) & 0xFu; }
#define XB_SPIN(cond, bar) do { unsigned _sp = 0; while (cond) { __builtin_amdgcn_s_sleep(1); \
    if ((++_sp & 255u) == 0u) { if (xb_ld(&(bar)[XB_TMO])) break; if (_sp > XB_SPIN_CAP) { atomicAdd(&(bar)[XB_TMO], 1u); break; } } } } while (0)

struct XcdBarrier {
    unsigned* bar; unsigned x;
    volatile LAS unsigned* st;
};

__device__ __forceinline__ XcdBarrier xcd_barrier_post(unsigned* bar, volatile LAS unsigned* st) {
    XcdBarrier b; b.bar = bar; b.x = xb_xcc_id(); b.st = st;
    if (threadIdx.x == 0) (void)xb_add(&bar[XB_XCNT(b.x)], 1u);
    return b;
}
__device__ __forceinline__ void xcd_barrier_complete(unsigned* bar, unsigned x, unsigned& nloc, unsigned& nx) {
    const unsigned G = gridDim.x * gridDim.y * gridDim.z;
    unsigned sum, cnt, mine, sp = 0u;
    for (;;) {
        sum = 0u; cnt = 0u; mine = 0u;
#pragma unroll
        for (unsigned j = 0; j < 16; ++j) { const unsigned c = xb_ld(&bar[XB_XCNT(j)]); sum += c; cnt += (c > 0u) ? 1u : 0u; mine = (j == x) ? c : mine; }
        if (sum == G) break;
        __builtin_amdgcn_s_sleep(1);
        if ((++sp & 255u) == 0u) { if (xb_ld(&bar[XB_TMO])) break; if (sp > XB_SPIN_CAP) { atomicAdd(&bar[XB_TMO], 1u); break; } }
    }
    nloc = mine > 0u ? mine : 1u; nx = cnt > 0u ? cnt : 1u;
}

__device__ __forceinline__ void xcd_barrier(const XcdBarrier& b) {
    asm volatile("s_waitcnt vmcnt(0)" ::: "memory");
    __syncthreads();
    if (threadIdx.x == 0) {
        unsigned* bar = b.bar;
        __builtin_amdgcn_s_waitcnt(0);
        unsigned nloc = b.st[0], nx = b.st[1];
        if (nloc == 0u) { xcd_barrier_complete(bar, b.x, nloc, nx); b.st[0] = nloc; b.st[1] = nx; }
        const unsigned old = xb_add(&bar[XB_XSUB(b.x)], 1u);
        const unsigned gen = old / nloc;
        if (old + 1u == (gen + 1u) * nloc) {
            __builtin_amdgcn_fence(__ATOMIC_RELEASE, "agent");
            asm volatile("s_waitcnt vmcnt(0)" ::: "memory");
            const unsigned og = xb_add(&bar[XB_TOP], 1u);
            const unsigned tg = og / nx;
            if (og + 1u == (tg + 1u) * nx) xb_add(&bar[XB_TOPGEN], 1u);
            else XB_SPIN(xb_ld(&bar[XB_TOPGEN]) == tg, bar);
            __builtin_amdgcn_fence(__ATOMIC_ACQUIRE, "agent");
            xb_add(&bar[XB_XGEN(b.x)], 1u);
            asm volatile("s_waitcnt vmcnt(0)" ::: "memory");
        } else {
            XB_SPIN(xb_ld(&bar[XB_XGEN(b.x)]) == gen, bar);
            __builtin_amdgcn_fence(__ATOMIC_ACQUIRE, "agent");
            asm volatile("s_waitcnt vmcnt(0)" ::: "memory");
        }
    }
    __syncthreads();
}


constexpr int NSTEPS = 19;
#ifndef PROBE_P0
#define PROBE_P0 0
#endif
#ifndef PROBE_OUT
#define PROBE_OUT 0
#endif
#ifndef PROBE_NA
#define PROBE_NA 0
#endif
#ifndef PROBE_SYNC
#define PROBE_SYNC 0
#endif
#ifndef PROBE_MLP1
#define PROBE_MLP1 0
#endif
#ifndef PROBE_MLP2
#define PROBE_MLP2 0
#endif
#ifndef PROBE_G1
#define PROBE_G1 0
#endif
#ifndef PROBE_K2
#define PROBE_K2 0
#endif
#ifndef PROBE_S3
#define PROBE_S3 0
#endif
#define IN(s) (lo <= (s) && (s) < hi)
#define SEAM(s) do { if (IN(s) && IN((s) + 1)) { if ((s) == 0) cg::this_grid().sync(); else xcd_barrier(xbar); for (int rs_ = 0; rs_ < PROBE_SYNC; ++rs_) xcd_barrier(xbar); } } while (0)
template <int LYR> __device__ __forceinline__ void layer_program(const Args& a, LAS unsigned char* L, const int lo, const int hi, const XcdBarrier& xbar) {
    constexpr int l = LYR;
    const int tid = threadIdx.x, lane = tid & 63, wave = __builtin_amdgcn_readfirstlane(tid >> 6);
    const int bid = blockIdx.x, G = gridDim.x;
    unsigned char* ws = a.ws;
        const int s0 = 1 + 9 * l;
        const bool last = (l == 1);
        const int mrows = last ? NLAT : MTOK;
        const float* modl = (const float*)(ws + WS_MOD) + (size_t)l * 3 * 12288;
        bf16* H = (bf16*)(ws + WS_H); bf16* Y = (bf16*)(ws + WS_Y); bf16* X = (bf16*)(ws + WS_X); bf16* P = (bf16*)(ws + WS_P); bf16* HID = (bf16*)(ws + WS_HID);
        if (IN(s0 + 0)) {
            if (l == 0) norm_phase<0, 0>(a.in[0], a.in[2], MTOK, a.in[6] + l * DM, modl, 0, 2048, H, lane, bid * 8 + wave, G * 8);
            else norm_phase<1, 1>(X, X + (size_t)NLAT * DM, MTOK, a.in[6] + l * DM, modl, 0, 2048, H, lane, bid * 8 + wave, G * 8,
                            (const float*)(ws + WS_PART), (const float*)(ws + WS_MOD) + 2 * 12288 + 10240, X + (size_t)NLAT * DM);
        }
        SEAM(s0 + 0);
        if (IN(s0 + 1)) {
#ifndef NO_GEMM
            pg8::Gemm g{H, (const bf16*)(ws + WS_WIN + l * SZ_WIN), MTOK, LDP, DM}; pg8::StaticOrder S; S.init(MTOK, LDP, G, bid);
            pg8::EpiStoreBf16<0> E{P, LDP};
            for (int rep = 0; rep < 1 + PROBE_G1; ++rep) pg8::gemm_phase<pg8::EpiStoreBf16<0>, pg8::StaticOrder, false, true>(L, g, S, E);
#endif
        }
        SEAM(s0 + 1);
        if (IN(s0 + 2)) {
            for (int rep = 0; rep < 1 + PROBE_K2; ++rep)
            for (int it = bid; it < 1088; it += G) {
                const int mx = ((it >> 8) + it + 1) & 1, r2 = it >> 1, bh = r2 / NSC, cc = r2 % NSC;
                const int seg = cc >= 4, c = seg ? cc - 4 : cc;
#ifndef NO_S1
                if (mx == 0) s1_item2<0>(a, l, P, bh, seg, c, L, tid, lane, wave); else s1_item2<1>(a, l, P, bh, seg, c, L, tid, lane, wave);
#endif
            }
        }
        SEAM(s0 + 2);
        if (IN(s0 + 3)) s2_phase(a, bid * NTHR + tid, G * NTHR);
        SEAM(s0 + 3);
        if (IN(s0 + 4)) {
            const int n_na = last ? 256 : 272;
            for (int rep = 0; rep < 1 + PROBE_S3 + PROBE_NA; ++rep)
            for (int it = bid; it < n_na + 1088; it += G) {
                if (rep > 0 && PROBE_NA && it >= n_na) continue;
                if (rep > 0 && PROBE_S3 && it < n_na) continue;
                if (it < n_na) {
#ifndef NO_NA
                    if (it < 256) { const int itx = (G == 256) ? ((it & 7) * 32 + (it >> 3)) : it;
                        const int b = itx >> 7, h = (itx >> 4) & 7, band = itx & 15; na_band(a, l, P, Y, b, h, band * 4, 1, L, tid, lane, wave); }
                    else { const int i2 = it - 256, b = i2 >> 3, h = i2 & 7; na_band(a, l, P, Y, b, h, 0, 0, L, tid, lane, wave); }
#endif
                } else {
                    const int i2 = it - n_na, mx = ((i2 >> 8) + i2 + 1) & 1, r2 = i2 >> 1, bh = r2 / NSC, cc = r2 % NSC;
                    const int seg = cc >= 4, c = seg ? cc - 4 : cc;
                    if (last && !seg) continue;
#ifndef NO_S3
                    if (mx == 0) s3_item<0>(a, l, P, Y, bh, seg, c, L, tid, lane, wave); else s3_item<1>(a, l, P, Y, bh, seg, c, L, tid, lane, wave);
#endif
                }
            }
        }
        SEAM(s0 + 4);
        if (IN(s0 + 5)) {
#ifndef NO_GEMM
            pg8::Gemm g{Y, (const bf16*)(ws + WS_WOUT + l * SZ_WOUT), NLAT, DM, DM}; pg8::StaticOrder S; S.init(NLAT, DM, G, bid);
            if (l == 0) { pg8::EpiResGateT<0, 1> E{a.in[0], X, modl + 4096}; pg8::gemm_phase<pg8::EpiResGateT<0, 1>, pg8::StaticOrder, false, true>(L, g, S, E); }
            else { pg8::EpiResGateT<1, 1> E{X, X, modl + 4096}; pg8::gemm_phase<pg8::EpiResGateT<1, 1>, pg8::StaticOrder, false, true>(L, g, S, E); }
            if (!last) sgemm_ctx<3>(Y + (size_t)NLAT * DM, (const bf16*)(ws + WS_WOUT + l * SZ_WOUT), DM, DM, 4, nullptr, (float*)(ws + WS_PART), L, tid, lane, wave, bid, G);
#endif
        }
        SEAM(s0 + 5);
        if (IN(s0 + 6)) {
            if (l == 0) norm_phase<1, 0>(X, a.in[2], MTOK, a.in[17] + l * DM, modl, 6144, 8192, H, lane, bid * 8 + wave, G * 8,
                                   (const float*)(ws + WS_PART), modl + 2 * 12288 + 4096, X + (size_t)NLAT * DM);
            else norm_phase<1, 1>(X, X + (size_t)NLAT * DM, NLAT, a.in[17] + l * DM, modl, 6144, 8192, H, lane, bid * 8 + wave, G * 8);
        }
        SEAM(s0 + 6);
        if (IN(s0 + 7)) {
#ifndef NO_GEMM
            pg8::Gemm g{H, (const bf16*)(ws + WS_W1 + l * SZ_W1), NLAT, DFF, DM}; pg8::StaticOrder S; S.init(NLAT, DFF, G, bid);
            pg8::EpiStoreBf16<2> E{HID, DFF};
            for (int rep = 0; rep < 1 + PROBE_MLP1; ++rep) pg8::gemm_phase<pg8::EpiStoreBf16<2>, pg8::StaticOrder, false, true>(L, g, S, E);
            if (!last) sgemm_ctx<1>(H + (size_t)NLAT * DM, (const bf16*)(ws + WS_W1 + l * SZ_W1), DM, DFF, 1, HID + (size_t)NLAT * DFF, nullptr, L, tid, lane, wave, bid, G);
#endif
        }
        SEAM(s0 + 7);
        if (IN(s0 + 8)) {
#ifndef NO_GEMM
            pg8::Gemm g{HID, (const bf16*)(ws + WS_W2 + l * SZ_W2), NLAT, DM, DFF}; pg8::StaticOrder S; S.init(NLAT, DM, G, bid);
            if (!last) { pg8::EpiResGateT<1, 1> E{X, X, modl + 10240}; pg8::gemm_phase<pg8::EpiResGateT<1, 1>, pg8::StaticOrder, false, true>(L, g, S, E); }
            else { pg8::EpiResGateT<1, 0> E{X, a.out, modl + 10240}; pg8::gemm_phase<pg8::EpiResGateT<1, 0>, pg8::StaticOrder, false, true>(L, g, S, E); }
            if (!last) sgemm_ctx<3>(HID + (size_t)NLAT * DFF, (const bf16*)(ws + WS_W2 + l * SZ_W2), DFF, DM, 4, nullptr, (float*)(ws + WS_PART), L, tid, lane, wave, bid, G);
#endif
        }
        SEAM(s0 + 8);
    }
__global__ void __launch_bounds__(NTHR, 2) mk_fwd(Args a) {
    __builtin_assume(__builtin_amdgcn_workitem_id_y() == 0); __builtin_assume(__builtin_amdgcn_workitem_id_z() == 0);
    extern __shared__ __attribute__((aligned(16))) unsigned char lds_raw[];
    LAS unsigned char* L = (LAS unsigned char*)lds_raw;
    const int lo = a.ph_lo, hi = a.ph_hi;
    if (threadIdx.x < 16) ((LAS unsigned*)(L + LDS_MISC))[threadIdx.x] = 0u;
    __syncthreads();
    if (blockIdx.x == 0) for (int i = threadIdx.x; i < 4096; i += NTHR) ((unsigned*)a.ws)[i] = 0u;
    cg::this_grid().sync();
    const XcdBarrier xbar = xcd_barrier_post((unsigned*)a.ws, (volatile LAS unsigned*)(L + LDS_MISC));
    if (IN(0)) {
#ifndef NO_P0
        const int tid = threadIdx.x;
        for (int rep = 0; rep < 1 + PROBE_P0; ++rep) { p0_phase(a, L, tid, tid & 63, __builtin_amdgcn_readfirstlane(tid >> 6), blockIdx.x, gridDim.x); __syncthreads(); }
#endif
    }
    if (IN(0) && IN(1)) xcd_barrier(xbar);
    layer_program<0>(a, L, lo, hi, xbar);
    layer_program<1>(a, L, lo, hi, xbar);
}
#undef IN
#undef SEAM

extern "C" void kernel_launch(void* const* d_in, const int* in_sizes, int n_in, void* d_out, int out_size, void* d_ws, size_t ws_size, hipStream_t stream) {
    static int grid = 0;
    if (grid == 0) {
        if (n_in != 20 || ws_size < WS_END) { fprintf(stderr, "kernel_launch: expected 20 inputs and >= %zu bytes of workspace (got %d, %zu)\n", (size_t)WS_END, n_in, ws_size); grid = -1; return; }
        int dev = 0, cus = 0, per_cu = 0;
        (void)hipGetDevice(&dev); (void)hipDeviceGetAttribute(&cus, hipDeviceAttributeMultiprocessorCount, dev);
        if (hipFuncSetAttribute((const void*)mk_fwd, hipFuncAttributeMaxDynamicSharedMemorySize, LDS_BYTES) != hipSuccess) { fprintf(stderr, "kernel_launch: hipFuncSetAttribute failed\n"); grid = -1; return; }
        if (hipOccupancyMaxActiveBlocksPerMultiprocessor(&per_cu, (const void*)mk_fwd, NTHR, LDS_BYTES) != hipSuccess || per_cu < 1) { fprintf(stderr, "kernel_launch: occupancy query gave %d\n", per_cu); per_cu = 1; }
        (void)hipGetLastError();
        grid = cus * per_cu;
        if (grid > 256) grid = 256;
    }
    if (grid < 0) return;
    Args a{};
    for (int i = 0; i < 20; ++i) a.in[i] = (const float*)d_in[i];
    a.out = (float*)d_out; a.ws = (unsigned char*)d_ws;
#if MK_ONE_LAUNCH
    a.ph_lo = 0; a.ph_hi = NSTEPS;
    void* args[] = {&a};
    hipError_t e = hipLaunchCooperativeKernel((const void*)mk_fwd, dim3(grid), dim3(NTHR), args, LDS_BYTES, stream);
    if (e != hipSuccess) fprintf(stderr, "kernel_launch: cooperative launch failed: %s (grid %d)\n", hipGetErrorString(e), grid);
#else
    for (int s = 0; s < NSTEPS; ++s) { a.ph_lo = s; a.ph_hi = s + 1; hipLaunchKernelGGL(mk_fwd, dim3(grid), dim3(NTHR), LDS_BYTES, stream, a); }
#endif
}
```

```cpp
#include <hip/hip_runtime.h>
#include <hip/hip_cooperative_groups.h>
#include <cstdio>
#include <cstdint>
namespace cg = cooperative_groups;
#ifndef MK_ONE_LAUNCH
#define MK_ONE_LAUNCH 1
#endif
namespace pg8 {
#define PG8_LAS __attribute__((address_space(3)))
typedef unsigned short bf16_t;
typedef short bf16x8 __attribute__((ext_vector_type(8)));
typedef float f32x4 __attribute__((ext_vector_type(4)));
typedef unsigned u32x4 __attribute__((ext_vector_type(4)));
constexpr int BM = 256, BK = 64, HALF = 128, HTB = HALF * BK * 2  , STAGE_BYTES = 8 * HTB, NXCD = 8, WGM = 8;

__host__ __device__ __forceinline__ int lds_byte(int r, int c) { const int st = (r >> 4) * 2 + (c >> 5), rr = r & 15, cc = c & 31, ob = rr * 64 + cc * 2; return st * 1024 + (ob ^ (((ob >> 9) & 1) << 5)); }
__host__ __device__ __forceinline__ void stage_rc(int b, int& R, int& C) { const int st = b / 1024, sb = b % 1024, swz = sb ^ (((sb >> 9) & 1) << 5); R = (st >> 1) * 16 + swz / 64; C = (st & 1) * 32 + (swz % 64) / 2; }
__host__ __device__ __forceinline__ int perm32(int rho) { const int n = rho >> 4, i = rho & 15; return 8 * (i >> 2) + 4 * n + (i & 3); }

struct Unit { int pm, pn; };
struct Gemm { const bf16_t* A; const bf16_t* Bt; int M, N, K; };

struct StaticOrder {
    int nM, nN, nwg, G, c;
    __host__ __device__ void init(int M, int N, int G_, int c_) { nM = M / BM; nN = N / BM; nwg = nM * nN; G = G_; c = c_; }
    __host__ __device__ bool next(int i, Unit& u) const {
        const long L = (long)i * G + c; if (L >= nwg) return false;
        int wgid = (int)L; { const int q = nwg / NXCD, r = nwg % NXCD, xcd = wgid % NXCD, off = wgid / NXCD; wgid = (xcd < r ? xcd * (q + 1) : r * (q + 1) + (xcd - r) * q) + off; }
        const int nig = WGM * nN, gid = wgid / nig, fm = gid * WGM, gsz = (nM - fm) < WGM ? (nM - fm) : WGM;
        u.pm = fm + ((wgid % nig) % gsz); u.pn = (wgid % nig) / gsz; return true;
    }
    __device__ __forceinline__ void a_ready(const Unit&) const {}
    __device__ __forceinline__ void done(const Unit&) const {}
};

__device__ __forceinline__ unsigned cvt_pk_bf16(float lo, float hi) { unsigned r; asm volatile("v_cvt_pk_bf16_f32 %0, %1, %2" : "=v"(r) : "v"(lo), "v"(hi)); return r; }
template <int ACT  > struct EpiStoreBf16 {
    static constexpr bool PERM = true, AFTER_DRAIN = false;
    bf16_t* O; int ldc;
    __device__ __forceinline__ void operator()(const f32x4 (&acc)[2][2][4][2], const Unit& u, int wr, int wc, int fr, int fq) const {
        asm volatile("s_nop 7\n\ts_nop 7\n\ts_nop 7" ::: "memory");
        const int row0 = u.pm * BM + wr * 64 + fr; const int col0 = u.pn * BM + wc * 32 + 8 * fq;
#pragma unroll
        for (int ai = 0; ai < 2; ++ai)
#pragma unroll
            for (int m = 0; m < 4; ++m) { bf16_t* rowp = O + (size_t)(row0 + ai * HALF + m * 16) * ldc + col0;
#pragma unroll
                for (int bj = 0; bj < 2; ++bj) { f32x4 v0 = acc[ai][bj][m][0], v1 = acc[ai][bj][m][1];
                    if (ACT == 2) {
#pragma unroll
                        for (int e = 0; e < 4; ++e) { float a0 = v0[e] > 0.f ? v0[e] : 0.f, a1 = v1[e] > 0.f ? v1[e] : 0.f; v0[e] = a0 * a0; v1[e] = a1 * a1; } }
                    u32x4 w; w.x = cvt_pk_bf16(v0[0], v0[1]); w.y = cvt_pk_bf16(v0[2], v0[3]); w.z = cvt_pk_bf16(v1[0], v1[1]); w.w = cvt_pk_bf16(v1[2], v1[3]);
                    *(u32x4*)(rowp + bj * HALF) = w; } }
    }
};
template <int RT, int OT> struct EpiResGateT {
    static constexpr bool PERM = true, AFTER_DRAIN = false;
    const void* res; void* out; const float* gate;
    static __device__ __forceinline__ f32x4 lo4(const u32x4& w) { f32x4 r; r.x = __builtin_bit_cast(float, w.x << 16); r.y = __builtin_bit_cast(float, w.x & 0xffff0000u); r.z = __builtin_bit_cast(float, w.y << 16); r.w = __builtin_bit_cast(float, w.y & 0xffff0000u); return r; }
    static __device__ __forceinline__ f32x4 hi4(const u32x4& w) { f32x4 r; r.x = __builtin_bit_cast(float, w.z << 16); r.y = __builtin_bit_cast(float, w.z & 0xffff0000u); r.z = __builtin_bit_cast(float, w.w << 16); r.w = __builtin_bit_cast(float, w.w & 0xffff0000u); return r; }
    __device__ __forceinline__ void operator()(const f32x4 (&acc)[2][2][4][2], const Unit& u, int wr, int wc, int fr, int fq) const {
        const int rt = u.pm * BM; const float* g = gate + (rt >> 12) * 12288;
        const int lr0 = rt + wr * 64 + fr, col0 = u.pn * BM + wc * 32 + 8 * fq;
#pragma unroll
        for (int bj = 0; bj < 2; ++bj) {
            const f32x4 gv0 = *(const f32x4*)(g + col0 + bj * HALF), gv1 = *(const f32x4*)(g + col0 + bj * HALF + 4);
            if (RT == 1) {
                u32x4 rw[2][4];
#pragma unroll
                for (int ai = 0; ai < 2; ++ai)
#pragma unroll
                    for (int m = 0; m < 4; ++m) rw[ai][m] = *(const u32x4*)((const bf16_t*)res + (size_t)(lr0 + ai * HALF + m * 16) * 2048 + col0 + bj * HALF);
#pragma unroll
                for (int ai = 0; ai < 2; ++ai)
#pragma unroll
                    for (int m = 0; m < 4; ++m) { const size_t off = (size_t)(lr0 + ai * HALF + m * 16) * 2048 + col0 + bj * HALF;
                        const f32x4 v0 = lo4(rw[ai][m]) + gv0 * acc[ai][bj][m][0], v1 = hi4(rw[ai][m]) + gv1 * acc[ai][bj][m][1];
                        if (OT == 0) { float* op = (float*)out + off; *(f32x4*)op = v0; *(f32x4*)(op + 4) = v1; }
                        else { u32x4 w; w.x = cvt_pk_bf16(v0[0], v0[1]); w.y = cvt_pk_bf16(v0[2], v0[3]); w.z = cvt_pk_bf16(v1[0], v1[1]); w.w = cvt_pk_bf16(v1[2], v1[3]);
                            *(u32x4*)((bf16_t*)out + off) = w; } }
            } else {
#pragma unroll
                for (int ai = 0; ai < 2; ++ai) {
                    f32x4 r[4][2];
#pragma unroll
                    for (int m = 0; m < 4; ++m) { const float* rp = (const float*)res + (size_t)(lr0 + ai * HALF + m * 16) * 2048 + col0 + bj * HALF; r[m][0] = *(const f32x4*)rp; r[m][1] = *(const f32x4*)(rp + 4); }
#pragma unroll
                    for (int m = 0; m < 4; ++m) { const size_t off = (size_t)(lr0 + ai * HALF + m * 16) * 2048 + col0 + bj * HALF;
                        const f32x4 v0 = r[m][0] + gv0 * acc[ai][bj][m][0], v1 = r[m][1] + gv1 * acc[ai][bj][m][1];
                        if (OT == 0) { float* op = (float*)out + off; *(f32x4*)op = v0; *(f32x4*)(op + 4) = v1; }
                        else { u32x4 w; w.x = cvt_pk_bf16(v0[0], v0[1]); w.y = cvt_pk_bf16(v0[2], v0[3]); w.z = cvt_pk_bf16(v1[0], v1[1]); w.w = cvt_pk_bf16(v1[2], v1[3]);
                            *(u32x4*)((bf16_t*)out + off) = w; } }
                }
            }
        }
    }
};
template <class Epi, class Sched, bool ALIGN_EPI = false, bool SP2 = false>
__device__ __forceinline__ void gemm_phase(PG8_LAS unsigned char* lds, const Gemm g, const Sched& S, const Epi& E) {
    const int tid = threadIdx.x, wid = __builtin_amdgcn_readfirstlane(tid >> 6), lane = tid & 63, wr = wid >> 2, wc = wid & 3, fr = lane & 15, fq = lane >> 4;
    const int K = g.K, nt = K / BK;
    unsigned voffA[2], voffB[2];
#pragma unroll
    for (int i = 0; i < 2; ++i) { int R, C; stage_rc(tid * 16 + i * 8192, R, C); const int Rb = Epi::PERM ? ((R & ~31) + perm32(R & 31)) : R;
        voffA[i] = (unsigned)(R * K + C) * 2u; voffB[i] = (unsigned)(Rb * K + C) * 2u; }
    const size_t kstep = (size_t)(BK * 2);
    const size_t hstep = (size_t)HALF * K * 2;
    const size_t tstep = 2 * hstep;
    const unsigned ldsw = (unsigned)wid * 1024u;
    const int aoff = lds_byte(wr * 64 + fr, fq * 8), boff = lds_byte(wc * 32 + fr, fq * 8);
#define PG8_SA(b, h) (((b) * 2 + (h)) * HTB)
#define PG8_SB(b, h) ((4 + (b) * 2 + (h)) * HTB)
#define PG8_STAGE(bufoff, gbase, voff) do { _Pragma("unroll") for (int _i = 0; _i < 2; ++_i) \
        __builtin_amdgcn_global_load_lds((const unsigned*)((const char*)(gbase) + (voff)[_i]), (PG8_LAS unsigned*)(lds + (bufoff) + ldsw + _i * 8192), 16, 0, 0); } while (0)
#define PG8_LDA(dst, b, h) do { _Pragma("unroll") for (int m = 0; m < 4; ++m) _Pragma("unroll") for (int k = 0; k < 2; ++k) dst[m][k] = *(const PG8_LAS bf16x8*)(lds + PG8_SA(b, h) + aoff + m * 2048 + k * 1024); } while (0)
#define PG8_LDB(dst, b, h) do { _Pragma("unroll") for (int n = 0; n < 2; ++n) _Pragma("unroll") for (int k = 0; k < 2; ++k) dst[n][k] = *(const PG8_LAS bf16x8*)(lds + PG8_SB(b, h) + boff + n * 2048 + k * 1024); } while (0)
#define PG8_MMA(ai, bj, At, Bt) do { __builtin_amdgcn_s_setprio(1); _Pragma("unroll") for (int m = 0; m < 4; ++m) _Pragma("unroll") for (int n = 0; n < 2; ++n) _Pragma("unroll") for (int k = 0; k < 2; ++k) \
        acc[ai][bj][m][n] = __builtin_amdgcn_mfma_f32_16x16x32_bf16(Bt[n][k], At[m][k], acc[ai][bj][m][n], 0, 0, 0); __builtin_amdgcn_s_setprio(0); } while (0)
#define PG8_WAIT_V(n) asm volatile("s_waitcnt vmcnt(" #n ")" ::: "memory")
#define PG8_WAIT_L(n) asm volatile("s_waitcnt lgkmcnt(" #n ")" ::: "memory")
#define PG8_BAR __builtin_amdgcn_s_barrier()
#define PG8_SCHED __builtin_amdgcn_sched_barrier(0)
    Unit cur, nxt; int ui = 0;
    if (!S.next(0, cur)) return;
    f32x4 acc[2][2][4][2];
#pragma unroll
    for (int a = 0; a < 2; ++a)
#pragma unroll
        for (int b = 0; b < 2; ++b)
#pragma unroll
            for (int m = 0; m < 4; ++m)
#pragma unroll
                for (int n = 0; n < 2; ++n) acc[a][b][m][n] = (f32x4){0.f, 0.f, 0.f, 0.f};
    bf16x8 At[4][2], B0[2][2], B1[2][2];
    const char* cA = (const char*)g.A + (size_t)cur.pm * tstep; const char* cB = (const char*)g.Bt + (size_t)cur.pn * tstep;
    S.a_ready(cur);
    if constexpr (SP2) {
        PG8_STAGE(PG8_SB(0, 0), cB, voffB); PG8_STAGE(PG8_SB(0, 1), cB + hstep, voffB); PG8_STAGE(PG8_SA(0, 0), cA, voffA); PG8_STAGE(PG8_SA(0, 1), cA + hstep, voffA);
        if (wr == 1) PG8_BAR;
        PG8_WAIT_V(2); PG8_BAR;
        PG8_STAGE(PG8_SB(1, 0), cB + kstep, voffB); PG8_STAGE(PG8_SA(1, 0), cA + kstep, voffA); PG8_STAGE(PG8_SB(1, 1), cB + hstep + kstep, voffB);
        PG8_WAIT_V(6); PG8_BAR;
    } else {
        PG8_STAGE(PG8_SB(0, 0), cB, voffB); PG8_STAGE(PG8_SA(0, 0), cA, voffA); PG8_STAGE(PG8_SB(0, 1), cB + hstep, voffB); PG8_STAGE(PG8_SA(0, 1), cA + hstep, voffA);
        if (wr == 1) PG8_BAR;
        PG8_WAIT_V(4); PG8_BAR;
        PG8_STAGE(PG8_SB(1, 0), cB + kstep, voffB); PG8_STAGE(PG8_SA(1, 0), cA + kstep, voffA); PG8_STAGE(PG8_SB(1, 1), cB + hstep + kstep, voffB);
        PG8_WAIT_V(6); PG8_BAR;
    }
    for (;;) {
        const bool has_next = S.next(ui + 1, nxt);
        const char* nA = has_next ? (const char*)g.A + (size_t)nxt.pm * tstep : cA; const char* nB = has_next ? (const char*)g.Bt + (size_t)nxt.pn * tstep : cB;
        for (int t = 0; t < nt; t += 2) {
            const bool last = (t == nt - 2);
            const char* a1 = cA + (size_t)(t + 1) * kstep;
            const char* a2 = last ? nA : cA + (size_t)(t + 2) * kstep; const char* b2 = last ? nB : cB + (size_t)(t + 2) * kstep;
            const char* a3 = a2 + kstep; const char* b3 = b2 + kstep;
            if (last && has_next) S.a_ready(nxt);
            if constexpr (SP2) {
            PG8_LDB(B0, 0, 0); PG8_LDB(B1, 0, 1); PG8_SCHED; PG8_LDA(At, 0, 0); PG8_STAGE(PG8_SA(1, 1), a1 + hstep, voffA);
            PG8_WAIT_V(8); PG8_WAIT_L(0); PG8_BAR; PG8_MMA(0, 0, At, B0); PG8_MMA(0, 1, At, B1); PG8_BAR; PG8_SCHED;
            PG8_LDA(At, 0, 1); PG8_STAGE(PG8_SB(0, 0), b2, voffB); PG8_STAGE(PG8_SB(0, 1), b2 + hstep, voffB); PG8_STAGE(PG8_SA(0, 0), a2, voffA);
            PG8_WAIT_V(8); PG8_WAIT_L(0); PG8_BAR; PG8_MMA(1, 0, At, B0); PG8_MMA(1, 1, At, B1); PG8_BAR; PG8_SCHED;
            PG8_LDB(B0, 1, 0); PG8_LDB(B1, 1, 1); PG8_SCHED; PG8_LDA(At, 1, 0); PG8_STAGE(PG8_SA(0, 1), a2 + hstep, voffA);
            PG8_WAIT_V(8); PG8_WAIT_L(0); PG8_BAR; PG8_MMA(0, 0, At, B0); PG8_MMA(0, 1, At, B1); PG8_BAR; PG8_SCHED;
            PG8_LDA(At, 1, 1); PG8_STAGE(PG8_SB(1, 0), b3, voffB); PG8_STAGE(PG8_SB(1, 1), b3 + hstep, voffB); PG8_STAGE(PG8_SA(1, 0), a3, voffA);
            PG8_WAIT_V(8); PG8_WAIT_L(0); PG8_BAR; PG8_MMA(1, 0, At, B0); PG8_MMA(1, 1, At, B1); PG8_BAR; PG8_SCHED;
            } else {
            PG8_LDB(B0, 0, 0); PG8_SCHED; PG8_LDA(At, 0, 0); PG8_STAGE(PG8_SA(1, 1), a1 + hstep, voffA);
            PG8_WAIT_L(8); PG8_BAR; PG8_WAIT_L(0); PG8_MMA(0, 0, At, B0); PG8_BAR; PG8_SCHED;
            PG8_LDB(B1, 0, 1); PG8_STAGE(PG8_SB(0, 0), b2, voffB);
            PG8_BAR; PG8_WAIT_L(0); PG8_MMA(0, 1, At, B1); PG8_BAR;
            PG8_LDA(At, 0, 1); PG8_STAGE(PG8_SA(0, 0), a2, voffA);
            PG8_BAR; PG8_WAIT_L(0); PG8_MMA(1, 0, At, B0); PG8_BAR; PG8_SCHED;
            PG8_STAGE(PG8_SB(0, 1), b2 + hstep, voffB);
            PG8_WAIT_V(6); PG8_BAR; PG8_MMA(1, 1, At, B1); PG8_BAR;
            PG8_LDB(B0, 1, 0); PG8_SCHED; PG8_LDA(At, 1, 0); PG8_STAGE(PG8_SA(0, 1), a2 + hstep, voffA);
            PG8_WAIT_L(8); PG8_BAR; PG8_WAIT_L(0); PG8_MMA(0, 0, At, B0); PG8_BAR; PG8_SCHED;
            PG8_LDB(B1, 1, 1); PG8_STAGE(PG8_SB(1, 0), b3, voffB);
            PG8_BAR; PG8_WAIT_L(0); PG8_MMA(0, 1, At, B1); PG8_BAR;
            PG8_LDA(At, 1, 1); PG8_STAGE(PG8_SA(1, 0), a3, voffA);
            PG8_BAR; PG8_WAIT_L(0); PG8_MMA(1, 0, At, B0); PG8_BAR; PG8_SCHED;
            PG8_STAGE(PG8_SB(1, 1), b3 + hstep, voffB);
            PG8_WAIT_V(6); PG8_BAR; PG8_MMA(1, 1, At, B1); PG8_BAR;
            }
        }
        if constexpr (ALIGN_EPI) { if (wr == 0) PG8_BAR; }
        if constexpr (!Epi::AFTER_DRAIN) { E(acc, cur, wr, wc, fr, fq); S.done(cur); }
        if (!has_next) break;
#pragma unroll
        for (int a = 0; a < 2; ++a)
#pragma unroll
            for (int b = 0; b < 2; ++b)
#pragma unroll
                for (int m = 0; m < 4; ++m)
#pragma unroll
                    for (int n = 0; n < 2; ++n) acc[a][b][m][n] = (f32x4){0.f, 0.f, 0.f, 0.f};
        cur = nxt; cA = nA; cB = nB; ++ui;
        if constexpr (ALIGN_EPI) { if (wr == 1) PG8_BAR; }
    }
    PG8_WAIT_V(0);
    if constexpr (!ALIGN_EPI) { if (wr == 0) PG8_BAR; }
    PG8_BAR;
    if constexpr (Epi::AFTER_DRAIN) { E.fused(acc, cur, wr, wc, fr, fq, lds, wid, lane); S.done(cur); }
#undef PG8_SA
#undef PG8_SB
#undef PG8_STAGE
#undef PG8_LDA
#undef PG8_LDB
#undef PG8_MMA
#undef PG8_WAIT_V
#undef PG8_WAIT_L
#undef PG8_BAR
#undef PG8_SCHED
}
}

#define LAS __attribute__((address_space(3)))
typedef unsigned short bf16;
typedef short bf16x8 __attribute__((ext_vector_type(8)));
typedef float f32x4 __attribute__((ext_vector_type(4)));
typedef float f32x2 __attribute__((ext_vector_type(2)));
typedef unsigned u32x4 __attribute__((ext_vector_type(4)));
typedef unsigned u32x2 __attribute__((ext_vector_type(2)));

constexpr int NTHR = 512;
constexpr int DM = 2048, SEQ = 4096, CTX = 256, NLAT = 8192, MTOK = 8704, DFF = 8192;
constexpr int INC = 7200, LDP = 7424;
constexpr int NSC = 68;
constexpr int C_GQ = 0, C_GK = 256, C_GV = 512, C_GR = 1024, C_GA = 1536;
constexpr int C_HQ = 1568, C_HF = 2080, C_HI = 3104, C_HG = 3616;
constexpr int C_NQ = 4128, C_NK = 5152, C_NV = 6176;
constexpr size_t MiB = 1u << 20;
constexpr size_t WS_MOD = 1 * MiB;
constexpr size_t WS_ROPE = 1 * MiB + 512 * 1024;
constexpr size_t WS_WIN = 2 * MiB, SZ_WIN = 29 * MiB;
constexpr size_t WS_WOUT = WS_WIN + 2 * SZ_WIN, SZ_WOUT = 8 * MiB;
constexpr size_t WS_W1 = WS_WOUT + 2 * SZ_WOUT, SZ_W1 = 32 * MiB;
constexpr size_t WS_W2 = WS_W1 + 2 * SZ_W1, SZ_W2 = 32 * MiB;
constexpr size_t WS_H = WS_W2 + 2 * SZ_W2;
constexpr size_t WS_Y = WS_H + 34 * MiB;
constexpr size_t WS_X = WS_Y + 34 * MiB;
constexpr size_t WS_U = WS_X + 68 * MiB;
constexpr size_t WS_P = WS_U, WS_HID = WS_U;
constexpr size_t WS_STG = WS_U + 124 * MiB;
constexpr size_t WS_STH = WS_STG + 34 * MiB;
constexpr size_t WS_DCG = WS_STH + 68 * MiB;
constexpr size_t WS_DCH = WS_DCG + 1 * MiB;
constexpr size_t WS_SBG = WS_DCH + 1 * MiB;
constexpr size_t WS_SBH = WS_SBG + 17 * MiB;
constexpr size_t WS_PART = WS_SBH + 34 * MiB;
constexpr size_t WS_END = WS_PART + 16 * MiB;
constexpr int LDS_BYTES = 147456, LDS_MISC = 147328;
constexpr size_t CTL_ZERO_BYTES = 65536;

struct Args { const float* in[20]; float* out; unsigned char* ws; int ph_lo, ph_hi; };

__device__ __forceinline__ unsigned f2bf(float f) { unsigned u = __builtin_bit_cast(unsigned, f); return (u + 0x7fffu + ((u >> 16) & 1u)) >> 16; }
__device__ __forceinline__ unsigned pk2(float lo, float hi) { return f2bf(lo) | (f2bf(hi) << 16); }
__device__ __forceinline__ float bf2f(unsigned h) { return __builtin_bit_cast(float, h << 16); }
__device__ __forceinline__ float wave_sum(float v) {
#pragma unroll
    for (int o = 1; o < 64; o <<= 1) v += __shfl_xor(v, o);
    return v;
}
__device__ __forceinline__ float wave_max(float v) {
#pragma unroll
    for (int o = 1; o < 64; o <<= 1) v = fmaxf(v, __shfl_xor(v, o));
    return v;
}
__device__ __forceinline__ float sigmoid_f(float x) { return 1.f / (1.f + __expf(-x)); }
__device__ __forceinline__ float silu_f(float x) { return x / (1.f + __expf(-x)); }
__device__ __forceinline__ float logsig_f(float x) { return fminf(x, 0.f) - __logf(1.f + __expf(-fabsf(x))); }
__device__ __forceinline__ bf16x8 frag(const LAS bf16* base, int ld, int row0, int k0, int lane) {
    return *(const LAS bf16x8*)(base + (row0 + (lane & 15)) * ld + k0 + (lane >> 4) * 8);
}
#define MFMA16(a, b, c) __builtin_amdgcn_mfma_f32_16x16x32_bf16((a), (b), (c), 0, 0, 0)

__device__ __forceinline__ void p0_transpose_item(const float* W, int K, int N, bf16* WT, LAS float* scr, int item, int lane) {
    const int nblk = N / 32, kb = item / nblk, nb = item % nblk, k0 = 64 * kb, n0 = 32 * nb;
#pragma unroll
    for (int i = 0; i < 32; ++i) { const int kk = 2 * i + (lane >> 5); scr[kk * 33 + (lane & 31)] = W[(size_t)(k0 + kk) * N + n0 + (lane & 31)]; }
    asm volatile("s_waitcnt lgkmcnt(0)" ::: "memory");
    const int c = lane & 7;
#pragma unroll
    for (int j = 0; j < 4; ++j) { const int n = (lane >> 3) + 8 * j; const LAS float* s = scr + (8 * c) * 33 + n;
        u32x4 o; o.x = pk2(s[0 * 33], s[1 * 33]); o.y = pk2(s[2 * 33], s[3 * 33]); o.z = pk2(s[4 * 33], s[5 * 33]); o.w = pk2(s[6 * 33], s[7 * 33]);
        *(u32x4*)(WT + (size_t)(n0 + n) * K + k0 + 8 * c) = o; }
    asm volatile("s_waitcnt lgkmcnt(0)" ::: "memory");
}

__device__ __forceinline__ void p0_phase(const Args& a, LAS unsigned char* L, int tid, int lane, int wave, int bid, int G) {
    unsigned char* ws = a.ws;
    float* MOD = (float*)(ws + WS_MOD);
    {
        LAS float* sv = (LAS float*)L;
        LAS float* red = (LAS float*)(L + 24576);
        for (int i = tid; i < 3 * 2048; i += NTHR) { const int s = i >> 11, k = i & 2047; const float c = s < 2 ? a.in[1][s * 2048 + k] : a.in[3][k]; sv[i] = silu_f(c); }
        __syncthreads();
        for (int it = bid; it < 256; it += G) {
            const int l = it >> 7, n0 = (it & 127) * 96;
            const float* W = a.in[4] + (size_t)l * 2048 * 12288 + n0;
            const int cgp = tid % 24, rg = tid / 24;
            float acc[3][4];
#pragma unroll
            for (int s = 0; s < 3; ++s)
#pragma unroll
                for (int j = 0; j < 4; ++j) acc[s][j] = 0.f;
            if (rg < 21) {
#pragma unroll 8
                for (int k = rg; k < 2048; k += 21) {
                    const f32x4 w = *(const f32x4*)(W + (size_t)k * 12288 + cgp * 4);
                    const float s0 = sv[k], s1 = sv[2048 + k], s2 = sv[4096 + k];
#pragma unroll
                    for (int j = 0; j < 4; ++j) { acc[0][j] += s0 * w[j]; acc[1][j] += s1 * w[j]; acc[2][j] += s2 * w[j]; }
                }
#pragma unroll
                for (int s = 0; s < 3; ++s)
#pragma unroll
                    for (int j = 0; j < 4; ++j) red[(rg * 3 + s) * 96 + cgp * 4 + j] = acc[s][j];
            }
            __syncthreads();
            if (tid < 288) { const int s = tid / 96, ci = tid % 96; float t = 0.f;
                for (int r2 = 0; r2 < 21; ++r2) t += red[(r2 * 3 + s) * 96 + ci];
                MOD[(size_t)(l * 3 + s) * 12288 + n0 + ci] = t + a.in[5][l * 12288 + n0 + ci]; }
            __syncthreads();
        }
    }
    if (bid == 0) {
        for (int u = tid; u < 1024; u += NTHR) { const int pos = u >> 4, i = u & 15;
            const float inv = (float)exp2(-(double)i * (13.287712379549449 / 16.0));
            const double ang = (double)pos * (double)inv;
            const double kq = rint(ang * 0.15915494309189535);
            const float rr = (float)(ang - kq * 6.283185307179586);
            f32x2 cs; cs.x = cosf(rr); cs.y = sinf(rr);
            ((f32x2*)(ws + WS_ROPE))[u] = cs; }
    }
    {
        LAS float* scr = (LAS float*)(L + wave * 16384);
        const int gw = bid * 8 + wave, NGW = G * 8;
        constexpr int I_IN = 32 * 225, I_OUT = 32 * 64, I_1 = 32 * 256, I_2 = 128 * 64, I_L = I_IN + I_OUT + I_1 + I_2;
        for (int it = gw; it < 2 * I_L; it += NGW) {
            const int l = it / I_L; int r = it % I_L;
            if (r < I_IN) { p0_transpose_item(a.in[7] + (size_t)l * DM * INC, DM, INC, (bf16*)(ws + WS_WIN + l * SZ_WIN), scr, r, lane); continue; } r -= I_IN;
            if (r < I_OUT) { p0_transpose_item(a.in[16] + (size_t)l * DM * DM, DM, DM, (bf16*)(ws + WS_WOUT + l * SZ_WOUT), scr, r, lane); continue; } r -= I_OUT;
            if (r < I_1) { p0_transpose_item(a.in[18] + (size_t)l * DM * DFF, DM, DFF, (bf16*)(ws + WS_W1 + l * SZ_W1), scr, r, lane); continue; } r -= I_1;
            p0_transpose_item(a.in[19] + (size_t)l * DFF * DM, DFF, DM, (bf16*)(ws + WS_W2 + l * SZ_W2), scr, r, lane);
        }
    }
}

template <int LT, int CT>
__device__ __forceinline__ void norm_load_row(const void* xlat, const void* xctx, int row, int lane, f32x4* v) {
    const bool isl = row < NLAT;
#pragma unroll
    for (int j = 0; j < 8; ++j) { const int c4 = lane + 64 * j;
        if (isl) { if (LT == 0) v[j] = ((const f32x4*)((const float*)xlat + (size_t)row * DM))[c4];
                   else { const u32x2 w = ((const u32x2*)((const bf16*)xlat + (size_t)row * DM))[c4]; v[j] = (f32x4){bf2f(w.x & 0xffffu), bf2f(w.x >> 16), bf2f(w.y & 0xffffu), bf2f(w.y >> 16)}; } }
        else { if (CT == 0) v[j] = ((const f32x4*)((const float*)xctx + (size_t)(row - NLAT) * DM))[c4];
               else { const u32x2 w = ((const u32x2*)((const bf16*)xctx + (size_t)(row - NLAT) * DM))[c4]; v[j] = (f32x4){bf2f(w.x & 0xffffu), bf2f(w.x >> 16), bf2f(w.y & 0xffffu), bf2f(w.y >> 16)}; } } }
}
template <int LT, int CT>
__device__ __forceinline__ void norm_phase(const void* xlat, const void* xctx, int nrows, const float* g, const float* modl, int sh_off, int sc_off, bf16* H, int lane, int gw, int NGW,
                                           const float* part = nullptr, const float* pgate = nullptr, bf16* xfin = nullptr) {
    f32x4 v[8], vn[8];
    if (gw < nrows) norm_load_row<LT, CT>(xlat, xctx, gw, lane, v);
    for (int row = gw; row < nrows; row += NGW) {
        if (row + NGW < nrows) norm_load_row<LT, CT>(xlat, xctx, row + NGW, lane, vn);
        const bool isl = row < NLAT;
        const int sg = isl ? (row >> 12) : 2;
        const float* sh = modl + sg * 12288 + sh_off; const float* sc = modl + sg * 12288 + sc_off;
        float ss = 0.f;
#pragma unroll
        for (int j = 0; j < 8; ++j) { const int c4 = lane + 64 * j;
            if (part != nullptr && !isl) {
                const size_t po = (size_t)(row - NLAT) * DM + c4 * 4;
                const f32x4 p0 = *(const f32x4*)(part + po), p1 = *(const f32x4*)(part + po + (size_t)512 * DM), p2 = *(const f32x4*)(part + po + (size_t)1024 * DM), p3 = *(const f32x4*)(part + po + (size_t)1536 * DM);
                v[j] = v[j] + ((const f32x4*)pgate)[c4] * ((p0 + p1) + (p2 + p3));
                u32x2 w; w.x = pk2(v[j].x, v[j].y); w.y = pk2(v[j].z, v[j].w); *(u32x2*)(xfin + po) = w; }
            ss += (v[j].x * v[j].x + v[j].y * v[j].y) + (v[j].z * v[j].z + v[j].w * v[j].w); }
        const float rstd = rsqrtf(wave_sum(ss) * (1.f / DM) + 1e-6f);
        u32x2* o8 = (u32x2*)(H + (size_t)row * DM);
#pragma unroll
        for (int j = 0; j < 8; ++j) { const int c4 = lane + 64 * j; const f32x4 g4 = ((const f32x4*)g)[c4], s4 = ((const f32x4*)sc)[c4], h4 = ((const f32x4*)sh)[c4];
            const f32x4 o = v[j] * rstd * g4 * (s4 + 1.f) + h4;
            u32x2 w; w.x = pk2(o.x, o.y); w.y = pk2(o.z, o.w); o8[c4] = w; }
#pragma unroll
        for (int j = 0; j < 8; ++j) v[j] = vn[j];
    }
}

typedef short s16x4 __attribute__((ext_vector_type(4)));
__device__ __forceinline__ bf16x8 frag_tr(const LAS bf16* base, int ld, int k0, int n0, int lane) {
    const int i = lane & 15;
    const LAS bf16* p = base + (k0 + (lane >> 4) * 8 + (i >> 2)) * ld + n0 + 4 * (i & 3);
    const s16x4 lo = __builtin_amdgcn_ds_read_tr16_b64_v4i16((LAS s16x4*)p);
    const s16x4 hi = __builtin_amdgcn_ds_read_tr16_b64_v4i16((LAS s16x4*)(p + 4 * ld));
    return (bf16x8){lo[0], lo[1], lo[2], lo[3], hi[0], hi[1], hi[2], hi[3]};
}
__device__ __forceinline__ float bfe(const u32x4& w, int e) { const unsigned x = w[e >> 1]; return __builtin_bit_cast(float, (e & 1) ? (x & 0xffff0000u) : (x << 16)); }
__device__ __forceinline__ unsigned cvtpk(float lo, float hi) { unsigned r; asm volatile("s_nop 1\n\tv_cvt_pk_bf16_f32 %0, %1, %2" : "=v"(r) : "v"(lo), "v"(hi)); return r; }
__device__ __forceinline__ u32x4 pack8(const float* v) { u32x4 w; w.x = cvtpk(v[0], v[1]); w.y = cvtpk(v[2], v[3]); w.z = cvtpk(v[4], v[5]); w.w = cvtpk(v[6], v[7]); return w; }

__device__ __forceinline__ void qknorm_pass(const Args& a, int l, bf16* P, int lane, int gw, int NGW) {
    const int sub = lane >> 4, li = lane & 15;
    const float* qn = a.in[13] + l * 128 + li * 8; const float* kn = a.in[14] + l * 128 + li * 8;
    float wq[8], wk[8];
#pragma unroll
    for (int e = 0; e < 8; ++e) { wq[e] = qn[e] * 0.08838834764831845f; wk[e] = kn[e]; }
#pragma unroll 2
    for (int u = gw * 4 + sub; u < MTOK * 16; u += NGW * 4) { const int row = u >> 4, hq = u & 15, isk = hq >> 3, h = hq & 7;
        bf16* p = P + (size_t)row * LDP + (isk ? C_NK : C_NQ) + h * 128 + li * 8;
        const u32x4 w = *(const u32x4*)p;
        float x[8], ss = 0.f;
#pragma unroll
        for (int e = 0; e < 8; ++e) { x[e] = bfe(w, e); ss += x[e] * x[e]; }
        ss += __shfl_xor(ss, 1); ss += __shfl_xor(ss, 2); ss += __shfl_xor(ss, 4); ss += __shfl_xor(ss, 8);
        const float rstd = rsqrtf(ss * (1.f / 128.f) + 1e-6f);
#pragma unroll
        for (int e = 0; e < 8; ++e) x[e] = x[e] * rstd * (isk ? wk[e] : wq[e]);
        *(u32x4*)p = pack8(x); }
}

__device__ __forceinline__ u32x4 norm8(const u32x4& w, const float* wt) {
    float x[8], ss = 0.f;
#pragma unroll
    for (int e = 0; e < 8; ++e) { x[e] = bfe(w, e); ss += x[e] * x[e]; }
    ss += __shfl_xor(ss, 1); ss += __shfl_xor(ss, 2); ss += __shfl_xor(ss, 4); ss += __shfl_xor(ss, 8);
    const float rstd = rsqrtf(ss * (1.f / 128.f) + 1e-6f);
#pragma unroll
    for (int e = 0; e < 8; ++e) x[e] = x[e] * rstd * wt[e];
    return pack8(x);
}
__device__ __forceinline__ void na_band(const Args& a, int l, const bf16* P, bf16* Y, int b, int h, int rbase, int nwin, LAS unsigned char* L, int tid, int lane, int wave) {
    asm volatile("" : "+v"(tid), "+v"(lane), "+s"(wave));
    LAS bf16* QN = (LAS bf16*)L;
    LAS bf16* KB = (LAS bf16*)(L + 69632);
    LAS bf16* VB = KB + 8704;
    LAS bf16* PB = (LAS bf16*)(L + 104448);
    LAS float* LS = (LAS float*)(L + 141312);
    LAS float* RB = (LAS float*)(L + 143360);
    LAS float* MISC = (LAS float*)(L + 145408);
    const float* rpb = a.in[15] + (size_t)(l * 8 + h) * 465;
    {
        const float rv = tid < 465 ? rpb[tid] : 0.f, qv = tid < 128 ? a.in[13][l * 128 + tid] : 0.f, kv = tid < 128 ? a.in[14][l * 128 + tid] : 0.f;
        if (tid < 465) RB[tid] = rv;
        const float m3 = wave_max(fabsf(rv)), m1 = wave_max(fabsf(qv)), m2 = wave_max(fabsf(kv));
        if (lane == 0) { MISC[1 + wave] = m3; MISC[9 + wave] = m1; MISC[17 + wave] = m2; }
    }
    const int uj = tid >> 4, uc = (tid & 15) * 8;
    const bf16* Ph = P + h * 128 + uc;
    float wq[8], wk[8];
#pragma unroll
    for (int e = 0; e < 8; ++e) { wq[e] = a.in[13][l * 128 + uc + e] * 0.08838834764831845f; wk[e] = a.in[14][l * 128 + uc + e]; }
    const int qrow0 = nwin ? b * SEQ + rbase * 64 : NLAT + b * CTX;
#pragma unroll
    for (int qb = 0; qb < 4; ++qb)
#pragma unroll
        for (int t = 0; t < 2; ++t) *(LAS u32x4*)(QN + qb * 8704 + (uj + 32 * t) * 136 + uc) = norm8(*(const u32x4*)(Ph + (size_t)(qrow0 + qb * 64 + uj + 32 * t) * LDP + C_NQ), wq);
    const int rlo = rbase - 4 < 0 ? 0 : (rbase - 4 > 56 ? 56 : rbase - 4), rhi3 = rbase - 1 < 0 ? 0 : (rbase - 1 > 56 ? 56 : rbase - 1);
    const int ntw = nwin ? (rhi3 + 8 - rlo) : 0, nt = ntw + 4;
    u32x4 rk[2], rv[2];
#define NA_LOADT(ti_) do { const int kr_ = (ti_) < ntw ? b * SEQ + (rlo + (ti_)) * 64 : NLAT + b * CTX + ((ti_) - ntw) * 64; \
        _Pragma("unroll") for (int t = 0; t < 2; ++t) { const bf16* pp_ = Ph + (size_t)(kr_ + uj + 32 * t) * LDP; rk[t] = *(const u32x4*)(pp_ + C_NK); rv[t] = *(const u32x4*)(pp_ + C_NV); } } while (0)
    NA_LOADT(0);
    const int qt = wave & 3, wg2 = wave >> 2, quad = lane >> 4, l15 = lane & 15;
    f32x4 o[4][4]; float lsum[4];
#pragma unroll
    for (int qb = 0; qb < 4; ++qb) { lsum[qb] = 0.f;
#pragma unroll
        for (int t = 0; t < 4; ++t) o[qb][t] = (f32x4){0.f, 0.f, 0.f, 0.f}; }
    const int qq = qt * 16 + l15, csq = qq - 8 < 0 ? 0 : (qq - 8 > 48 ? 48 : qq - 8);
    unsigned wmask = 0u;
#pragma unroll
    for (int t2 = 0; t2 < 2; ++t2)
#pragma unroll
        for (int jj = 0; jj < 4; ++jj) { const int kc = (wg2 * 2 + t2) * 16 + quad * 4 + jj; if (kc >= csq && kc < csq + 16) wmask |= 1u << (t2 * 4 + jj); }
    const int dcb = wg2 * 32 + quad * 4 - qq + 15;
    float shift = 0.f;
#pragma unroll 1
    for (int ti = 0; ti < nt; ++ti) {
        __syncthreads();
#pragma unroll
        for (int t = 0; t < 2; ++t) { *(LAS u32x4*)(KB + (uj + 32 * t) * 136 + uc) = norm8(rk[t], wk); *(LAS u32x4*)(VB + (uj + 32 * t) * 136 + uc) = rv[t]; }
        if (ti + 1 < nt) NA_LOADT(ti + 1);
        __syncthreads();
        { float m3 = 0.f, m1 = 0.f, m2 = 0.f;
#pragma unroll
          for (int w8 = 0; w8 < 8; ++w8) { m3 = fmaxf(m3, MISC[1 + w8]); m1 = fmaxf(m1, MISC[9 + w8]); m2 = fmaxf(m2, MISC[17 + w8]); }
          shift = 11.313708499f * m1 * m2 + m3; }
        const int kr = rlo + ti;
        const bool win = ti < ntw;
        const unsigned msk = win ? wmask : 0xffu;
        {
            __builtin_amdgcn_s_setprio(1);
            bf16x8 kf[2][4];
#pragma unroll
            for (int t2 = 0; t2 < 2; ++t2)
#pragma unroll
                for (int ks = 0; ks < 4; ++ks) kf[t2][ks] = frag(KB, 136, (wg2 * 2 + t2) * 16, ks * 32, lane);
#pragma unroll
            for (int qb = 0; qb < 4; ++qb) {
                const int rq = rbase + qb, r0q = rq - 4 < 0 ? 0 : (rq - 4 > 56 ? 56 : rq - 4);
                const bool use = !win || (kr >= r0q && kr < r0q + 8);
                if (use) {
                    const LAS float* rbr = RB + (win ? (kr - rq + 7) * 31 : 0);
                    f32x4 sT[2];
                    sT[0] = (f32x4){0.f, 0.f, 0.f, 0.f}; sT[1] = (f32x4){0.f, 0.f, 0.f, 0.f};
#pragma unroll
                    for (int ks = 0; ks < 4; ++ks) { const bf16x8 qf = frag(QN + qb * 8704, 136, qt * 16, ks * 32, lane);
                        sT[0] = MFMA16(kf[0][ks], qf, sT[0]); sT[1] = MFMA16(kf[1][ks], qf, sT[1]); }
#pragma unroll
                    for (int t2 = 0; t2 < 2; ++t2) { const int ktile = wg2 * 2 + t2;
                        float pv[4];
#pragma unroll
                        for (int jj = 0; jj < 4; ++jj) { const bool valid = (msk >> (t2 * 4 + jj)) & 1u;
                            int bi = dcb + 16 * t2 + jj; bi = bi < 0 ? 0 : (bi > 30 ? 30 : bi);
                            const float bias = win ? rbr[bi] : 0.f;
                            pv[jj] = valid ? __expf(sT[t2][jj] + bias - shift) : 0.f; lsum[qb] += pv[jj]; }
                        u32x2 w; w.x = cvtpk(pv[0], pv[1]); w.y = cvtpk(pv[2], pv[3]);
                        *(LAS u32x2*)(PB + qb * 4608 + qq * 72 + ktile * 16 + quad * 4) = w; }
                }
            }
            __builtin_amdgcn_s_setprio(0);
        }
        __syncthreads();
        {
            __builtin_amdgcn_s_setprio(1);
            bf16x8 vf[2][4];
#pragma unroll
            for (int ks = 0; ks < 2; ++ks)
#pragma unroll
                for (int t = 0; t < 4; ++t) vf[ks][t] = frag_tr(VB, 136, ks * 32, (wg2 * 4 + t) * 16, lane);
#pragma unroll
            for (int qb = 0; qb < 4; ++qb) {
                const int rq = rbase + qb, r0q = rq - 4 < 0 ? 0 : (rq - 4 > 56 ? 56 : rq - 4);
                const bool use = !win || (kr >= r0q && kr < r0q + 8);
                if (use) {
#pragma unroll
                    for (int ks = 0; ks < 2; ++ks) { const bf16x8 af = frag(PB + qb * 4608, 72, qt * 16, ks * 32, lane);
#pragma unroll
                        for (int t = 0; t < 4; ++t) o[qb][t] = MFMA16(af, vf[ks][t], o[qb][t]); }
                }
            }
            __builtin_amdgcn_s_setprio(0);
        }
    }
#undef NA_LOADT
#pragma unroll
    for (int qb = 0; qb < 4; ++qb) { float v = lsum[qb]; v += __shfl_xor(v, 16); v += __shfl_xor(v, 32);
        if (quad == 0) LS[qb * 128 + wg2 * 64 + qq] = v; }
    __syncthreads();
#pragma unroll
    for (int qb = 0; qb < 4; ++qb)
#pragma unroll
        for (int jj = 0; jj < 4; ++jj) { const int q = qt * 16 + quad * 4 + jj; const float inv = 1.f / (LS[qb * 128 + q] + LS[qb * 128 + 64 + q]);
            bf16* yr = Y + (size_t)(qrow0 + qb * 64 + q) * DM + 1024 + h * 128 + wg2 * 64 + l15;
#pragma unroll
            for (int t = 0; t < 4; ++t) yr[t * 16] = (bf16)f2bf(o[qb][t][jj] * inv); }
    __syncthreads();
}

template <int MX> __device__ __forceinline__ void load_unit(const Args& a, const bf16* prow, int h, int dg, int seg, int c, int jtok, int dir, bool need_q,
                                                              const float* lbv, const LAS float* W2L, float* q, float* k, float* g) {
    if (MX == 0) {
        const u32x4 a0 = *(const u32x4*)(prow + C_GA + dir * 16), a1 = *(const u32x4*)(prow + C_GA + dir * 16 + 8);
        float s[8];
#pragma unroll
        for (int e = 0; e < 8; ++e) s[e] = W2L[1024 + dg * 8 + e];
#pragma unroll
        for (int r = 0; r < 16; ++r) { const float al = r < 8 ? bfe(a0, r) : bfe(a1, r - 8);
            const f32x4 w0 = *(const LAS f32x4*)(W2L + r * 64 + dg * 8), w1 = *(const LAS f32x4*)(W2L + r * 64 + dg * 8 + 4);
#pragma unroll
            for (int e = 0; e < 4; ++e) { s[e] += al * w0[e]; s[4 + e] += al * w1[e]; }
            if ((r & 3) == 3) __builtin_amdgcn_sched_barrier(0); }
#pragma unroll
        for (int e = 0; e < 8; ++e) g[e] = logsig_f(s[e]) * (1.f / 16.f);
        const int odd = (dg >> 1) & 1, hf = dg >> 2, i0 = (dg & 1) * 8;
        float cs[8], sn[8];
        if (seg) { const f32x4* rp = (const f32x4*)((const f32x2*)(a.ws + WS_ROPE) + (hf ? jtok : c) * 16 + i0);
#pragma unroll
            for (int e2 = 0; e2 < 4; ++e2) { const f32x4 t = rp[e2]; cs[2 * e2] = t.x; sn[2 * e2] = t.y; cs[2 * e2 + 1] = t.z; sn[2 * e2 + 1] = t.w; } }
        else {
#pragma unroll
            for (int e = 0; e < 8; ++e) { cs[e] = 1.f; sn[e] = 0.f; } }
        { const u32x4 ow = *(const u32x4*)(prow + C_GK + h * 64 + dg * 8), pw = *(const u32x4*)(prow + C_GK + h * 64 + (dg ^ 2) * 8);
#pragma unroll
            for (int e = 0; e < 8; ++e) { const float own = bfe(ow, e), par = bfe(pw, e); k[e] = odd ? (par * sn[e] + own * cs[e]) : (own * cs[e] - par * sn[e]); } }
        if (need_q) { const u32x4 ow = *(const u32x4*)(prow + C_GQ + h * 64 + dg * 8), pw = *(const u32x4*)(prow + C_GQ + h * 64 + (dg ^ 2) * 8);
#pragma unroll
            for (int e = 0; e < 8; ++e) { const float own = bfe(ow, e) * 0.125f, par = bfe(pw, e) * 0.125f; q[e] = odd ? (par * sn[e] + own * cs[e]) : (own * cs[e] - par * sn[e]); } }
    } else {
        const u32x4 fw = *(const u32x4*)(prow + C_HF + dir * 512 + h * 128 + dg * 8);
#pragma unroll
        for (int e = 0; e < 8; ++e) { const float ex = __expf(-bfe(fw, e)), sg = 1.f / (1.f + ex), lb = lbv[e];
            g[e] = __logf(lb + (1.f - lb) * sg); k[e] = (1.f - lb) * (ex * sg); }
        if (need_q) { const u32x4 qw = *(const u32x4*)(prow + C_HQ + h * 128 + dg * 8);
#pragma unroll
            for (int e = 0; e < 8; ++e) q[e] = silu_f(bfe(qw, e)); }
    }
}
__device__ __forceinline__ void load_lb(const Args& a, int l, int dir, int h, int dg, float* lbv) {
    const float* hlb = a.in[11];
#pragma unroll
    for (int e = 0; e < 8; ++e) { float lb = 0.f;
        if (l == 1) { const float b0 = hlb[dir * 512 + h * 128 + dg * 8 + e], b1 = hlb[(2 + dir) * 512 + h * 128 + dg * 8 + e]; lb = 1.f / (1.f + __expf(b0 - b1)); }
        lbv[e] = lb; }
}
__device__ __forceinline__ void stage_w2(const Args& a, int l, int dir, int h, LAS float* W2L, int tid) {
    const float* w2 = a.in[8] + (size_t)((l * 2 + dir) * 16) * 256 + h * 64;
    const float* ba = a.in[9] + (l * 2 + dir) * 256 + h * 64;
    const float v0 = w2[(tid >> 6) * 256 + (tid & 63)], v1 = w2[((tid + 512) >> 6) * 256 + (tid & 63)], v2 = tid < 64 ? ba[tid] : 0.f;
    W2L[tid] = v0; W2L[tid + 512] = v1; if (tid < 64) W2L[1024 + tid] = v2;
}
template <int DK> __device__ __forceinline__ void cumsum_p(LAS float* CF, LAS float* SG, int tid) {
    constexpr int CS = DK + 4, NSEG = NTHR / DK, SL = 64 / NSEG;
    const int d = tid % DK, sg = tid / DK;
    float run = 0.f;
#pragma unroll 4
    for (int p = sg * SL; p < sg * SL + SL; ++p) { run += CF[p * CS + d]; CF[p * CS + d] = run; }
    SG[sg * DK + d] = run;
    __syncthreads();
    float off = 0.f;
    for (int s2 = 0; s2 < sg; ++s2) off += SG[s2 * DK + d];
#pragma unroll 4
    for (int p = sg * SL; p < sg * SL + SL; ++p) CF[p * CS + d] += off;
    __syncthreads();
}
__device__ __forceinline__ int scan_chunk(int seg, int c, int dir) { return seg ? 4 + (dir ? 63 - c : c) : (dir ? 3 - c : c); }

template <int MX> __device__ __forceinline__ void s1_item(const Args& a, int l, const bf16* P, int bh, int seg, int c, int dir, LAS unsigned char* L, int tid, int lane, int wave) {
    asm volatile("" : "+v"(tid), "+v"(lane), "+s"(wave));
    constexpr int DK = MX ? 128 : 64, DB = DK + 8, CS = DK + 4, NDG = DK / 8, UPT = (64 * NDG) / NTHR, NT = DK / 16;
    LAS float* CF = (LAS float*)L;
    LAS bf16* KB = (LAS bf16*)(L + 33792);
    LAS bf16* VB = (LAS bf16*)(L + 51200);
    LAS float* SG = (LAS float*)(L + 68608);
    LAS float* W2L = (LAS float*)(L + 70656);
    const int b = bh >> 2, h = bh & 3;
    const int row0 = seg ? b * SEQ + c * 64 : NLAT + b * CTX + c * 64;
    const int vcol = (MX ? C_HI : C_GV) + h * 128;
    if (MX == 0) stage_w2(a, l, dir, h, W2L, tid);
#pragma unroll
    for (int t = 0; t < 2; ++t) { const int u = tid + NTHR * t, p = u >> 4, ch = u & 15, j = dir ? 63 - p : p;
        *(LAS u32x4*)(VB + p * 136 + ch * 8) = *(const u32x4*)(P + (size_t)(row0 + j) * LDP + vcol + ch * 8); }
    __syncthreads();
    float kv[UPT][8];
    {
        float lbv[8];
        if (MX == 1) load_lb(a, l, dir, h, tid % NDG, lbv);
#pragma unroll
        for (int t = 0; t < UPT; ++t) { const int u = tid + NTHR * t, p = u / NDG, dg = u % NDG, j = dir ? 63 - p : p;
            float g[8], qd[8];
            load_unit<MX>(a, P + (size_t)(row0 + j) * LDP, h, dg, seg, c, j, dir, false, lbv, W2L, qd, kv[t], g);
            *(LAS f32x4*)(CF + p * CS + dg * 8) = (f32x4){g[0], g[1], g[2], g[3]}; *(LAS f32x4*)(CF + p * CS + dg * 8 + 4) = (f32x4){g[4], g[5], g[6], g[7]}; }
    }
    __syncthreads();
    cumsum_p<DK>(CF, SG, tid);
#pragma unroll
    for (int t = 0; t < UPT; ++t) { const int u = tid + NTHR * t, p = u / NDG, dg = u % NDG;
        float o[8];
#pragma unroll
        for (int e = 0; e < 8; ++e) o[e] = kv[t][e] * __expf(CF[63 * CS + dg * 8 + e] - CF[p * CS + dg * 8 + e]);
        *(LAS u32x4*)(KB + p * DB + dg * 8) = pack8(o); }
    const int sc = scan_chunk(seg, c, dir);
    const size_t sidx = (size_t)((bh * 2 + dir) * NSC + sc);
    float* ST = (float*)(a.ws + (MX ? WS_STH : WS_STG)) + sidx * (DK * 128);
    float* DC = (float*)(a.ws + (MX ? WS_DCH : WS_DCG)) + sidx * DK;
    if (tid < DK) DC[tid] = __expf(CF[63 * CS + tid]);
    __syncthreads();
    const int dt = wave % NT, vb = (wave / NT) * NT, quad = lane >> 4, l15 = lane & 15;
    f32x4 acc[NT];
#pragma unroll
    for (int t = 0; t < NT; ++t) acc[t] = (f32x4){0.f, 0.f, 0.f, 0.f};
#pragma unroll
    for (int ks = 0; ks < 2; ++ks) { const bf16x8 af = frag_tr(KB, DB, ks * 32, dt * 16, lane);
#pragma unroll
        for (int t = 0; t < NT; ++t) acc[t] = MFMA16(af, frag_tr(VB, 136, ks * 32, (vb + t) * 16, lane), acc[t]); }
#pragma unroll
    for (int t = 0; t < NT; ++t)
#pragma unroll
        for (int jj = 0; jj < 4; ++jj) ST[(dt * 16 + quad * 4 + jj) * 128 + (vb + t) * 16 + l15] = acc[t][jj];
    __syncthreads();
}

template <int DK> __device__ __forceinline__ void cumsum_p2(LAS float* CF0, LAS float* CF1, LAS float* SG, int tid) {
    constexpr int CS = DK + 4, NSEG = NTHR / DK, SL = 64 / NSEG;
    const int d = tid % DK, sg = tid / DK;
    float run0 = 0.f, run1 = 0.f;
#pragma unroll 4
    for (int p = sg * SL; p < sg * SL + SL; ++p) { run0 += CF0[p * CS + d]; CF0[p * CS + d] = run0; run1 += CF1[p * CS + d]; CF1[p * CS + d] = run1; }
    SG[sg * DK + d] = run0; SG[512 + sg * DK + d] = run1;
    __syncthreads();
    float off0 = 0.f, off1 = 0.f;
    for (int s2 = 0; s2 < sg; ++s2) { off0 += SG[s2 * DK + d]; off1 += SG[512 + s2 * DK + d]; }
#pragma unroll 4
    for (int p = sg * SL; p < sg * SL + SL; ++p) { CF0[p * CS + d] += off0; CF1[p * CS + d] += off1; }
    __syncthreads();
}
template <int MX> __device__ __forceinline__ void s1_item2(const Args& a, int l, const bf16* P, int bh, int seg, int c, LAS unsigned char* L, int tid, int lane, int wave) {
    asm volatile("" : "+v"(tid), "+v"(lane), "+s"(wave));
    constexpr int DK = MX ? 128 : 64, DB = DK + 8, CS = DK + 4, NDG = DK / 8, UPT = (64 * NDG) / NTHR, NT = DK / 16;
    LAS float* CF0 = (LAS float*)L;
    LAS float* CF1 = (LAS float*)(L + 33792);
    LAS bf16* KB0 = (LAS bf16*)(L + 67584);
    LAS bf16* KB1 = (LAS bf16*)(L + 84992);
    LAS bf16* VB = (LAS bf16*)(L + 102400);
    LAS float* SG = (LAS float*)(L + 119808);
    LAS float* W2L = (LAS float*)(L + 123904);
    const int b = bh >> 2, h = bh & 3;
    const int row0 = seg ? b * SEQ + c * 64 : NLAT + b * CTX + c * 64;
    const int vcol = (MX ? C_HI : C_GV) + h * 128;
    if (MX == 0) { stage_w2(a, l, 0, h, W2L, tid); stage_w2(a, l, 1, h, W2L + 1088, tid); }
#pragma unroll
    for (int t = 0; t < 2; ++t) { const int u = tid + NTHR * t, j = u >> 4, ch = u & 15;
        *(LAS u32x4*)(VB + j * 136 + ch * 8) = *(const u32x4*)(P + (size_t)(row0 + j) * LDP + vcol + ch * 8); }
    __syncthreads();
    float kv0[UPT][8], kv1[UPT][8];
    {
        float lbv0[8], lbv1[8];
        if (MX == 1) { load_lb(a, l, 0, h, tid % NDG, lbv0); load_lb(a, l, 1, h, tid % NDG, lbv1); }
#pragma unroll
        for (int t = 0; t < UPT; ++t) { const int u = tid + NTHR * t, j = u / NDG, dg = u % NDG;
            float g0[8], g1[8], qd[8];
            load_unit<MX>(a, P + (size_t)(row0 + j) * LDP, h, dg, seg, c, j, 0, false, lbv0, W2L, qd, kv0[t], g0);
            *(LAS f32x4*)(CF0 + j * CS + dg * 8) = (f32x4){g0[0], g0[1], g0[2], g0[3]}; *(LAS f32x4*)(CF0 + j * CS + dg * 8 + 4) = (f32x4){g0[4], g0[5], g0[6], g0[7]};
            __builtin_amdgcn_sched_barrier(0);
            load_unit<MX>(a, P + (size_t)(row0 + j) * LDP, h, dg, seg, c, j, 1, false, lbv1, W2L + 1088, qd, kv1[t], g1);
            *(LAS f32x4*)(CF1 + (63 - j) * CS + dg * 8) = (f32x4){g1[0], g1[1], g1[2], g1[3]}; *(LAS f32x4*)(CF1 + (63 - j) * CS + dg * 8 + 4) = (f32x4){g1[4], g1[5], g1[6], g1[7]};
            __builtin_amdgcn_sched_barrier(0); }
    }
    __syncthreads();
    cumsum_p2<DK>(CF0, CF1, SG, tid);
#pragma unroll
    for (int t = 0; t < UPT; ++t) { const int u = tid + NTHR * t, j = u / NDG, dg = u % NDG;
        float o[8];
#pragma unroll
        for (int e = 0; e < 8; ++e) o[e] = kv0[t][e] * __expf(CF0[63 * CS + dg * 8 + e] - CF0[j * CS + dg * 8 + e]);
        *(LAS u32x4*)(KB0 + j * DB + dg * 8) = pack8(o);
#pragma unroll
        for (int e = 0; e < 8; ++e) o[e] = kv1[t][e] * __expf(CF1[63 * CS + dg * 8 + e] - CF1[(63 - j) * CS + dg * 8 + e]);
        *(LAS u32x4*)(KB1 + j * DB + dg * 8) = pack8(o); }
    const size_t sidx0 = (size_t)((bh * 2 + 0) * NSC + scan_chunk(seg, c, 0)), sidx1 = (size_t)((bh * 2 + 1) * NSC + scan_chunk(seg, c, 1));
    bf16* STb = (bf16*)(a.ws + (MX ? WS_STH : WS_STG)); float* DCb = (float*)(a.ws + (MX ? WS_DCH : WS_DCG));
    if (tid < DK) { DCb[sidx0 * DK + tid] = __expf(CF0[63 * CS + tid]); DCb[sidx1 * DK + tid] = __expf(CF1[63 * CS + tid]); }
    __syncthreads();
    const int dt = wave % NT, vb = (wave / NT) * NT;
#pragma unroll 1
    for (int dir = 0; dir < 2; ++dir) {
        int lane2 = lane; asm volatile("" : "+v"(lane2));
        const int quad = lane2 >> 4, l15 = lane2 & 15;
        const LAS bf16* KB = dir ? KB1 : KB0; bf16* ST = STb + (dir ? sidx1 : sidx0) * (DK * 128);
        f32x4 acc[NT];
#pragma unroll
        for (int t = 0; t < NT; ++t) acc[t] = (f32x4){0.f, 0.f, 0.f, 0.f};
#pragma unroll
        for (int ks = 0; ks < 2; ++ks) { const bf16x8 kfr = frag_tr(KB, DB, ks * 32, dt * 16, lane2);
#pragma unroll
            for (int t = 0; t < NT; ++t) acc[t] = MFMA16(frag_tr(VB, 136, ks * 32, (vb + t) * 16, lane2), kfr, acc[t]); }
#pragma unroll
        for (int t = 0; t < NT; ++t) { u32x2 w; w.x = pk2(acc[t][0], acc[t][1]); w.y = pk2(acc[t][2], acc[t][3]);
            *(u32x2*)(ST + (dt * 16 + l15) * 128 + (vb + t) * 16 + quad * 4) = w; }
    }
    __syncthreads();
}

__device__ __forceinline__ void s2_phase(const Args& a, int gtid, int nthreads) {
    for (int e4 = gtid; e4 < 98304; e4 += nthreads) {
        const bf16* st; bf16* sb; const float* dc; int ss, sd;
        if (e4 < 32768) { const int sq = e4 >> 11, rem = (e4 & 2047) * 4; st = (const bf16*)(a.ws + WS_STG) + (size_t)sq * NSC * 8192 + rem; sb = (bf16*)(a.ws + WS_SBG) + (size_t)sq * NSC * 8192 + rem;
            dc = (const float*)(a.ws + WS_DCG) + sq * NSC * 64 + (rem >> 7); ss = 8192; sd = 64; }
        else { const int e2 = e4 - 32768, sq = e2 >> 12, rem = (e2 & 4095) * 4; st = (const bf16*)(a.ws + WS_STH) + (size_t)sq * NSC * 16384 + rem; sb = (bf16*)(a.ws + WS_SBH) + (size_t)sq * NSC * 16384 + rem;
            dc = (const float*)(a.ws + WS_DCH) + sq * NSC * 128 + (rem >> 7); ss = 16384; sd = 128; }
        f32x4 S = (f32x4){0.f, 0.f, 0.f, 0.f};
#pragma unroll 17
        for (int sc = 0; sc < NSC; ++sc) { const u32x2 lw = *(const u32x2*)(st + (size_t)sc * ss); const float dv = dc[sc * sd];
            const f32x4 Lv = (f32x4){bf2f(lw.x & 0xffffu), bf2f(lw.x >> 16), bf2f(lw.y & 0xffffu), bf2f(lw.y >> 16)};
            u32x2 w; w.x = pk2(S.x, S.y); w.y = pk2(S.z, S.w); *(u32x2*)(sb + (size_t)sc * ss) = w; S = S * dv + Lv; }
    }
}

template <int MX> __device__ __forceinline__ void s3_item(const Args& a, int l, const bf16* P, bf16* Y, int bh, int seg, int c, LAS unsigned char* L, int tid, int lane, int wave) {
    asm volatile("" : "+v"(tid), "+v"(lane), "+s"(wave));
    constexpr int DK = MX ? 128 : 64, DB = DK + 8, CS = DK + 4, NDG = DK / 8, UPT = (64 * NDG) / NTHR, NS0 = (DK * 16) / NTHR;
    LAS float* CF = (LAS float*)L;
    LAS bf16* QT = (LAS bf16*)(L + 33792);
    LAS bf16* KD = (LAS bf16*)(L + 51200);
    LAS bf16* KO = (LAS bf16*)(L + 68608);
    LAS bf16* S0B = (LAS bf16*)(L + 51200);
    LAS bf16* QS = (LAS bf16*)(L + 94720);
    LAS bf16* VB = (LAS bf16*)(L + 112128);
    LAS bf16* ATT = (LAS bf16*)(L + 129536);
    LAS float* SG = (LAS float*)(L + 138752);
    LAS float* W2L = (LAS float*)(L + 140800);
    LAS float* OF = (LAS float*)L;
    const int b = bh >> 2, h = bh & 3;
    const int row0 = seg ? b * SEQ + c * 64 : NLAT + b * CTX + c * 64;
    const int vcol = (MX ? C_HI : C_GV) + h * 128;
    const int it_ = wave & 3, vb = (wave >> 2) * 4, quad = lane >> 4, l15 = lane & 15;
    f32x4 acc[4];
#pragma unroll
    for (int t = 0; t < 4; ++t) acc[t] = (f32x4){0.f, 0.f, 0.f, 0.f};
#pragma unroll
    for (int t = 0; t < 2; ++t) { const int u = tid + NTHR * t, j = u >> 4, ch = u & 15;
        *(LAS u32x4*)(VB + j * 136 + ch * 8) = *(const u32x4*)(P + (size_t)(row0 + j) * LDP + vcol + ch * 8); }
#pragma unroll 1
    for (int dir = 0; dir < 2; ++dir) {
        if (MX == 0) { stage_w2(a, l, dir, h, W2L, tid); __syncthreads(); }
        float qv[UPT][8], kv[UPT][8];
        {
            float lbv[8];
            if (MX == 1) load_lb(a, l, dir, h, tid % NDG, lbv);
#pragma unroll
            for (int t = 0; t < UPT; ++t) { const int u = tid + NTHR * t, p = u / NDG, dg = u % NDG, j = dir ? 63 - p : p;
                float g[8];
                load_unit<MX>(a, P + (size_t)(row0 + j) * LDP, h, dg, seg, c, j, dir, true, lbv, W2L, qv[t], kv[t], g);
                *(LAS f32x4*)(CF + p * CS + dg * 8) = (f32x4){g[0], g[1], g[2], g[3]}; *(LAS f32x4*)(CF + p * CS + dg * 8 + 4) = (f32x4){g[4], g[5], g[6], g[7]}; }
        }
        __syncthreads();
        cumsum_p<DK>(CF, SG, tid);
#pragma unroll
        for (int t = 0; t < UPT; ++t) { const int u = tid + NTHR * t, p = u / NDG, dg = u % NDG, j = dir ? 63 - p : p, sa = p >> 4;
            float cc[8], rf[8], o[8];
            { const f32x4 c0 = *(const LAS f32x4*)(CF + p * CS + dg * 8), c1 = *(const LAS f32x4*)(CF + p * CS + dg * 8 + 4);
#pragma unroll
              for (int e = 0; e < 4; ++e) { cc[e] = c0[e]; cc[4 + e] = c1[e]; } }
            if (sa > 0) { const f32x4 r0 = *(const LAS f32x4*)(CF + (16 * sa - 1) * CS + dg * 8), r1 = *(const LAS f32x4*)(CF + (16 * sa - 1) * CS + dg * 8 + 4);
#pragma unroll
              for (int e = 0; e < 4; ++e) { rf[e] = r0[e]; rf[4 + e] = r1[e]; } }
            else {
#pragma unroll
              for (int e = 0; e < 8; ++e) rf[e] = 0.f; }
#pragma unroll
            for (int e = 0; e < 8; ++e) o[e] = qv[t][e] * __expf(cc[e] - rf[e]);
            *(LAS u32x4*)(QT + p * DB + dg * 8) = pack8(o);
#pragma unroll
            for (int e = 0; e < 8; ++e) o[e] = kv[t][e] * __expf(fminf(rf[e] - cc[e], 80.f));
            *(LAS u32x4*)(KD + p * DB + dg * 8) = pack8(o);
#pragma unroll
            for (int e = 0; e < 8; ++e) o[e] = qv[t][e] * __expf(cc[e]);
            *(LAS u32x4*)(QS + j * DB + dg * 8) = pack8(o);
            for (int a2 = sa + 1; a2 < 4; ++a2) { const f32x4 r0 = *(const LAS f32x4*)(CF + (16 * a2 - 1) * CS + dg * 8), r1 = *(const LAS f32x4*)(CF + (16 * a2 - 1) * CS + dg * 8 + 4);
#pragma unroll
                for (int e = 0; e < 4; ++e) { o[e] = kv[t][e] * __expf(r0[e] - cc[e]); o[4 + e] = kv[t][4 + e] * __expf(r1[e] - cc[4 + e]); }
                *(LAS u32x4*)(KO + ((a2 == 1 ? 0 : (a2 == 2 ? 16 : 48)) + p) * DB + dg * 8) = pack8(o); }
        }
        u32x4 s0r[NS0];
        {
            const int sc = scan_chunk(seg, c, dir);
            const bf16* SB = (const bf16*)(a.ws + (MX ? WS_SBH : WS_SBG)) + (size_t)((bh * 2 + dir) * NSC + sc) * (DK * 128);
#pragma unroll
            for (int t = 0; t < NS0; ++t) s0r[t] = *(const u32x4*)(SB + (size_t)(tid + NTHR * t) * 8);
        }
        __syncthreads();
#pragma unroll
        for (int t2 = 0; t2 < 2; ++t2) { const int s = wave * 2 + t2, sa = s >> 2, sb = s & 3;
            f32x4 sacc = (f32x4){0.f, 0.f, 0.f, 0.f};
            if (sb <= sa) {
                const LAS bf16* kb = (sa == sb) ? KD + (16 * sa) * DB : KO + ((sa == 1 ? 0 : (sa == 2 ? 16 : 48)) + 16 * sb) * DB;
#pragma unroll
                for (int ks = 0; ks < DK / 32; ++ks) sacc = MFMA16(frag(kb, DB, 0, ks * 32, lane), frag(QT, DB, 16 * sa, ks * 32, lane), sacc);
            }
            float v[4];
#pragma unroll
            for (int jj = 0; jj < 4; ++jj) v[jj] = (sb < sa || (sb == sa && quad * 4 + jj <= l15)) ? sacc[jj] : 0.f;
            const int p = 16 * sa + l15, pp0 = 16 * sb + quad * 4;
            u32x2 w;
            if (dir) { w.x = cvtpk(v[3], v[2]); w.y = cvtpk(v[1], v[0]); *(LAS u32x2*)(ATT + (63 - p) * 72 + 60 - pp0) = w; }
            else { w.x = cvtpk(v[0], v[1]); w.y = cvtpk(v[2], v[3]); *(LAS u32x2*)(ATT + p * 72 + pp0) = w; } }
        __syncthreads();
#pragma unroll
        for (int t = 0; t < NS0; ++t) { const int u = tid + NTHR * t, d = u >> 4, ch = u & 15; *(LAS u32x4*)(S0B + d * 136 + ch * 8) = s0r[t]; }
        __syncthreads();
        __builtin_amdgcn_s_setprio(1);
#pragma unroll
        for (int ks = 0; ks < 2; ++ks) { const bf16x8 af = frag(ATT, 72, it_ * 16, ks * 32, lane);
#pragma unroll
            for (int t = 0; t < 4; ++t) acc[t] = MFMA16(af, frag_tr(VB, 136, ks * 32, (vb + t) * 16, lane), acc[t]); }
#pragma unroll
        for (int ks = 0; ks < DK / 32; ++ks) { const bf16x8 af = frag(QS, DB, it_ * 16, ks * 32, lane);
#pragma unroll
            for (int t = 0; t < 4; ++t) acc[t] = MFMA16(af, frag_tr(S0B, 136, ks * 32, (vb + t) * 16, lane), acc[t]); }
        __builtin_amdgcn_s_setprio(0);
        __syncthreads();
    }
    const int gcol = (MX ? C_HG : C_GR) + h * 128, ycol = (MX ? 512 : 0) + h * 128;
    unsigned gwv[8];
#pragma unroll
    for (int rr = 0; rr < 8; ++rr) gwv[rr] = *(const unsigned*)(P + (size_t)(row0 + wave * 8 + rr) * LDP + gcol + lane * 2);
#pragma unroll
    for (int t = 0; t < 4; ++t)
#pragma unroll
        for (int jj = 0; jj < 4; ++jj) OF[(it_ * 16 + quad * 4 + jj) * 132 + (vb + t) * 16 + l15] = acc[t][jj];
    __syncthreads();
    const float* ng = (MX ? a.in[12] : a.in[10]) + l * 128;
    const float n0 = ng[lane * 2], n1 = ng[lane * 2 + 1];
#pragma unroll
    for (int rr = 0; rr < 8; ++rr) { const int i = wave * 8 + rr;
        const float o0 = OF[i * 132 + lane * 2], o1 = OF[i * 132 + lane * 2 + 1];
        const float rstd = rsqrtf(wave_sum(o0 * o0 + o1 * o1) * (1.f / 128.f) + 1e-6f);
        const unsigned gw = gwv[rr];
        const float y0 = o0 * rstd * n0 * silu_f(bf2f(gw & 0xffffu)), y1 = o1 * rstd * n1 * silu_f(bf2f(gw >> 16));
        *(unsigned*)(Y + (size_t)(row0 + i) * DM + ycol + lane * 2) = pk2(y0, y1); }
    __syncthreads();
}


template <int MODE> __device__ __forceinline__ void sgemm_ctx(const bf16* A, const bf16* Bt, int K, int N, int S, bf16* O, float* PART,
                                                              LAS unsigned char* L, int tid, int lane, int wave, int bid, int G) {
    const int ntn = N / 128, nitems = 4 * ntn * S, kspan = K / S, ns = kspan / 128;
    const int uj = tid >> 4, uc = (tid & 15) * 8;
    const int wm = wave & 3, wn = wave >> 2, quad = lane >> 4, l15 = lane & 15;
#pragma unroll 1
    for (int it = bid; it < nitems; it += G) {
        const int sp = it % S, r1 = it / S, tn = r1 % ntn, tm = r1 / ntn;
        const bf16* Ap = A + (size_t)(tm * 128 + uj) * K + sp * kspan + uc; const bf16* Bp = Bt + (size_t)(tn * 128 + uj) * K + sp * kspan + uc;
        u32x4 ra[4], rb[4], rc[4], rd[4];
#define SG_LOAD(ra_, rb_, st_) do { _Pragma("unroll") for (int t = 0; t < 4; ++t) { ra_[t] = *(const u32x4*)(Ap + (size_t)(32 * t) * K + (st_) * 128); rb_[t] = *(const u32x4*)(Bp + (size_t)(32 * t) * K + (st_) * 128); } } while (0)
#define SG_STORE(ra_, rb_, buf_) do { LAS bf16* An_ = (LAS bf16*)L + (buf_) * 34816; _Pragma("unroll") for (int t = 0; t < 4; ++t) { *(LAS u32x4*)(An_ + (uj + 32 * t) * 136 + uc) = ra_[t]; *(LAS u32x4*)(An_ + 17408 + (uj + 32 * t) * 136 + uc) = rb_[t]; } } while (0)
#define SG_COMPUTE(buf_) do { const LAS bf16* As = (const LAS bf16*)L + (buf_) * 34816; const LAS bf16* Bs = As + 17408; __builtin_amdgcn_s_setprio(1); \
            _Pragma("unroll") for (int ks = 0; ks < 4; ++ks) { const bf16x8 af0 = frag(As, 136, wm * 32, ks * 32, lane), af1 = frag(As, 136, wm * 32 + 16, ks * 32, lane); \
                _Pragma("unroll") for (int t = 0; t < 4; ++t) { const bf16x8 bfm = frag(Bs, 136, wn * 64 + t * 16, ks * 32, lane); \
                    acc[0][t] = MFMA16(af0, bfm, acc[0][t]); acc[1][t] = MFMA16(af1, bfm, acc[1][t]); } } __builtin_amdgcn_s_setprio(0); } while (0)
        SG_LOAD(ra, rb, 0);
        if (ns > 1) SG_LOAD(rc, rd, 1);
        SG_STORE(ra, rb, 0);
        if (ns > 2) SG_LOAD(ra, rb, 2);
        __syncthreads();
        f32x4 acc[2][4];
#pragma unroll
        for (int i = 0; i < 2; ++i)
#pragma unroll
            for (int t = 0; t < 4; ++t) acc[i][t] = (f32x4){0.f, 0.f, 0.f, 0.f};
#pragma unroll 1
        for (int s = 0; s < ns; s += 2) {
            SG_COMPUTE(0);
            if (s + 1 < ns) SG_STORE(rc, rd, 1);
            if (s + 3 < ns) SG_LOAD(rc, rd, s + 3);
            __syncthreads();
            if (s + 1 < ns) {
                SG_COMPUTE(1);
                if (s + 2 < ns) SG_STORE(ra, rb, 0);
                if (s + 4 < ns) SG_LOAD(ra, rb, s + 4);
                __syncthreads();
            }
        }
#undef SG_LOAD
#undef SG_STORE
#undef SG_COMPUTE
#pragma unroll
        for (int i = 0; i < 2; ++i)
#pragma unroll
            for (int t = 0; t < 4; ++t) { const int col = tn * 128 + wn * 64 + t * 16 + l15;
#pragma unroll
                for (int jj = 0; jj < 4; ++jj) { const int row = tm * 128 + wm * 32 + i * 16 + quad * 4 + jj;
                    if (MODE == 1) { const float v = acc[i][t][jj] > 0.f ? acc[i][t][jj] : 0.f; O[(size_t)row * N + col] = (bf16)f2bf(v * v); }
                    else PART[((size_t)sp * 512 + row) * N + col] = acc[i][t][jj]; } }
    }
}

#define XB_TMO      128
#define XB_XCNT(j)  (256  + 64 * (j))
#define XB_XSUB(j)  (1280 + 64 * (j))
#define XB_XGEN(j)  (2304 + 64 * (j))
#define XB_TOP      3328
#define XB_TOPGEN   3392
#define XCD_BAR_WORDS 3456
#define XB_SPIN_CAP (1u << 18)

__device__ __forceinline__ unsigned xb_ld(unsigned* p)              { return __hip_atomic_load(p, __ATOMIC_RELAXED, __HIP_MEMORY_SCOPE_AGENT); }
__device__ __forceinline__ unsigned xb_add(unsigned* p, unsigned v) { return __hip_atomic_fetch_add(p, v, __ATOMIC_RELAXED, __HIP_MEMORY_SCOPE_AGENT); }
__device__ __forceinline__ unsigned xb_xcc_id() { return (unsigned)__builtin_amdgcn_s_getreg((3 << 11) | 20) & 0xFu; }
#define XB_SPIN(cond, bar) do { unsigned _sp = 0; while (cond) { __builtin_amdgcn_s_sleep(1); \
    if ((++_sp & 255u) == 0u) { if (xb_ld(&(bar)[XB_TMO])) break; if (_sp > XB_SPIN_CAP) { atomicAdd(&(bar)[XB_TMO], 1u); break; } } } } while (0)

struct XcdBarrier {
    unsigned* bar; unsigned x;
    volatile LAS unsigned* st;
};

__device__ __forceinline__ XcdBarrier xcd_barrier_post(unsigned* bar, volatile LAS unsigned* st) {
    XcdBarrier b; b.bar = bar; b.x = xb_xcc_id(); b.st = st;
    if (threadIdx.x == 0) (void)xb_add(&bar[XB_XCNT(b.x)], 1u);
    return b;
}
__device__ __forceinline__ void xcd_barrier_complete(unsigned* bar, unsigned x, unsigned& nloc, unsigned& nx) {
    const unsigned G = gridDim.x * gridDim.y * gridDim.z;
    unsigned sum, cnt, mine, sp = 0u;
    for (;;) {
        sum = 0u; cnt = 0u; mine = 0u;
#pragma unroll
        for (unsigned j = 0; j < 16; ++j) { const unsigned c = xb_ld(&bar[XB_XCNT(j)]); sum += c; cnt += (c > 0u) ? 1u : 0u; mine = (j == x) ? c : mine; }
        if (sum == G) break;
        __builtin_amdgcn_s_sleep(1);
        if ((++sp & 255u) == 0u) { if (xb_ld(&bar[XB_TMO])) break; if (sp > XB_SPIN_CAP) { atomicAdd(&bar[XB_TMO], 1u); break; } }
    }
    nloc = mine > 0u ? mine : 1u; nx = cnt > 0u ? cnt : 1u;
}

__device__ __forceinline__ void xcd_barrier(const XcdBarrier& b) {
    asm volatile("s_waitcnt vmcnt(0)" ::: "memory");
    __syncthreads();
    if (threadIdx.x == 0) {
        unsigned* bar = b.bar;
        __builtin_amdgcn_s_waitcnt(0);
        unsigned nloc = b.st[0], nx = b.st[1];
        if (nloc == 0u) { xcd_barrier_complete(bar, b.x, nloc, nx); b.st[0] = nloc; b.st[1] = nx; }
        const unsigned old = xb_add(&bar[XB_XSUB(b.x)], 1u);
        const unsigned gen = old / nloc;
        if (old + 1u == (gen + 1u) * nloc) {
            __builtin_amdgcn_fence(__ATOMIC_RELEASE, "agent");
            asm volatile("s_waitcnt vmcnt(0)" ::: "memory");
            const unsigned og = xb_add(&bar[XB_TOP], 1u);
            const unsigned tg = og / nx;
            if (og + 1u == (tg + 1u) * nx) xb_add(&bar[XB_TOPGEN], 1u);
            else XB_SPIN(xb_ld(&bar[XB_TOPGEN]) == tg, bar);
            __builtin_amdgcn_fence(__ATOMIC_ACQUIRE, "agent");
            xb_add(&bar[XB_XGEN(b.x)], 1u);
            asm volatile("s_waitcnt vmcnt(0)" ::: "memory");
        } else {
            XB_SPIN(xb_ld(&bar[XB_XGEN(b.x)]) == gen, bar);
            __builtin_amdgcn_fence(__ATOMIC_ACQUIRE, "agent");
            asm volatile("s_waitcnt vmcnt(0)" ::: "memory");
        }
    }
    __syncthreads();
}


constexpr int NSTEPS = 19;
#ifndef PROBE_P0
#define PROBE_P0 0
#endif
#ifndef PROBE_OUT
#define PROBE_OUT 0
#endif
#ifndef PROBE_NA
#define PROBE_NA 0
#endif
#ifndef PROBE_SYNC
#define PROBE_SYNC 0
#endif
#ifndef PROBE_MLP1
#define PROBE_MLP1 0
#endif
#ifndef PROBE_MLP2
#define PROBE_MLP2 0
#endif
#ifndef PROBE_G1
#define PROBE_G1 0
#endif
#ifndef PROBE_K2
#define PROBE_K2 0
#endif
#ifndef PROBE_S3
#define PROBE_S3 0
#endif
#define IN(s) (lo <= (s) && (s) < hi)
#define SEAM(s) do { if (IN(s) && IN((s) + 1)) { if ((s) == 0) cg::this_grid().sync(); else xcd_barrier(xbar); for (int rs_ = 0; rs_ < PROBE_SYNC; ++rs_) xcd_barrier(xbar); } } while (0)
template <int LYR> __device__ __forceinline__ void layer_program(const Args& a, LAS unsigned char* L, const int lo, const int hi, const XcdBarrier& xbar) {
    constexpr int l = LYR;
    const int tid = threadIdx.x, lane = tid & 63, wave = __builtin_amdgcn_readfirstlane(tid >> 6);
    const int bid = blockIdx.x, G = gridDim.x;
    unsigned char* ws = a.ws;
        const int s0 = 1 + 9 * l;
        const bool last = (l == 1);
        const int mrows = last ? NLAT : MTOK;
        const float* modl = (const float*)(ws + WS_MOD) + (size_t)l * 3 * 12288;
        bf16* H = (bf16*)(ws + WS_H); bf16* Y = (bf16*)(ws + WS_Y); bf16* X = (bf16*)(ws + WS_X); bf16* P = (bf16*)(ws + WS_P); bf16* HID = (bf16*)(ws + WS_HID);
        if (IN(s0 + 0)) {
            if (l == 0) norm_phase<0, 0>(a.in[0], a.in[2], MTOK, a.in[6] + l * DM, modl, 0, 2048, H, lane, bid * 8 + wave, G * 8);
            else norm_phase<1, 1>(X, X + (size_t)NLAT * DM, MTOK, a.in[6] + l * DM, modl, 0, 2048, H, lane, bid * 8 + wave, G * 8,
                            (const float*)(ws + WS_PART), (const float*)(ws + WS_MOD) + 2 * 12288 + 10240, X + (size_t)NLAT * DM);
        }
        SEAM(s0 + 0);
        if (IN(s0 + 1)) {
#ifndef NO_GEMM
            pg8::Gemm g{H, (const bf16*)(ws + WS_WIN + l * SZ_WIN), MTOK, LDP, DM}; pg8::StaticOrder S; S.init(MTOK, LDP, G, bid);
            pg8::EpiStoreBf16<0> E{P, LDP};
            for (int rep = 0; rep < 1 + PROBE_G1; ++rep) pg8::gemm_phase<pg8::EpiStoreBf16<0>, pg8::StaticOrder, false, true>(L, g, S, E);
#endif
        }
        SEAM(s0 + 1);
        if (IN(s0 + 2)) {
            for (int rep = 0; rep < 1 + PROBE_K2; ++rep)
            for (int it = bid; it < 1088; it += G) {
                const int mx = ((it >> 8) + it + 1) & 1, r2 = it >> 1, bh = r2 / NSC, cc = r2 % NSC;
                const int seg = cc >= 4, c = seg ? cc - 4 : cc;
#ifndef NO_S1
                if (mx == 0) s1_item2<0>(a, l, P, bh, seg, c, L, tid, lane, wave); else s1_item2<1>(a, l, P, bh, seg, c, L, tid, lane, wave);
#endif
            }
        }
        SEAM(s0 + 2);
        if (IN(s0 + 3)) s2_phase(a, bid * NTHR + tid, G * NTHR);
        SEAM(s0 + 3);
        if (IN(s0 + 4)) {
            const int n_na = last ? 256 : 272;
            for (int rep = 0; rep < 1 + PROBE_S3 + PROBE_NA; ++rep)
            for (int it = bid; it < n_na + 1088; it += G) {
                if (rep > 0 && PROBE_NA && it >= n_na) continue;
                if (rep > 0 && PROBE_S3 && it < n_na) continue;
                if (it < n_na) {
#ifndef NO_NA
                    if (it < 256) { const int itx = (G == 256) ? ((it & 7) * 32 + (it >> 3)) : it;
                        const int b = itx >> 7, h = (itx >> 4) & 7, band = itx & 15; na_band(a, l, P, Y, b, h, band * 4, 1, L, tid, lane, wave); }
                    else { const int i2 = it - 256, b = i2 >> 3, h = i2 & 7; na_band(a, l, P, Y, b, h, 0, 0, L, tid, lane, wave); }
#endif
                } else {
                    const int i2 = it - n_na, mx = ((i2 >> 8) + i2 + 1) & 1, r2 = i2 >> 1, bh = r2 / NSC, cc = r2 % NSC;
                    const int seg = cc >= 4, c = seg ? cc - 4 : cc;
                    if (last && !seg) continue;
#ifndef NO_S3
                    if (mx == 0) s3_item<0>(a, l, P, Y, bh, seg, c, L, tid, lane, wave); else s3_item<1>(a, l, P, Y, bh, seg, c, L, tid, lane, wave);
#endif
                }
            }
        }
        SEAM(s0 + 4);
        if (IN(s0 + 5)) {
#ifndef NO_GEMM
            pg8::Gemm g{Y, (const bf16*)(ws + WS_WOUT + l * SZ_WOUT), NLAT, DM, DM}; pg8::StaticOrder S; S.init(NLAT, DM, G, bid);
            if (l == 0) { pg8::EpiResGateT<0, 1> E{a.in[0], X, modl + 4096}; pg8::gemm_phase<pg8::EpiResGateT<0, 1>, pg8::StaticOrder, false, true>(L, g, S, E); }
            else { pg8::EpiResGateT<1, 1> E{X, X, modl + 4096}; pg8::gemm_phase<pg8::EpiResGateT<1, 1>, pg8::StaticOrder, false, true>(L, g, S, E); }
            if (!last) sgemm_ctx<3>(Y + (size_t)NLAT * DM, (const bf16*)(ws + WS_WOUT + l * SZ_WOUT), DM, DM, 4, nullptr, (float*)(ws + WS_PART), L, tid, lane, wave, bid, G);
#endif
        }
        SEAM(s0 + 5);
        if (IN(s0 + 6)) {
            if (l == 0) norm_phase<1, 0>(X, a.in[2], MTOK, a.in[17] + l * DM, modl, 6144, 8192, H, lane, bid * 8 + wave, G * 8,
                                   (const float*)(ws + WS_PART), modl + 2 * 12288 + 4096, X + (size_t)NLAT * DM);
            else norm_phase<1, 1>(X, X + (size_t)NLAT * DM, NLAT, a.in[17] + l * DM, modl, 6144, 8192, H, lane, bid * 8 + wave, G * 8);
        }
        SEAM(s0 + 6);
        if (IN(s0 + 7)) {
#ifndef NO_GEMM
            pg8::Gemm g{H, (const bf16*)(ws + WS_W1 + l * SZ_W1), NLAT, DFF, DM}; pg8::StaticOrder S; S.init(NLAT, DFF, G, bid);
            pg8::EpiStoreBf16<2> E{HID, DFF};
            for (int rep = 0; rep < 1 + PROBE_MLP1; ++rep) pg8::gemm_phase<pg8::EpiStoreBf16<2>, pg8::StaticOrder, false, true>(L, g, S, E);
            if (!last) sgemm_ctx<1>(H + (size_t)NLAT * DM, (const bf16*)(ws + WS_W1 + l * SZ_W1), DM, DFF, 1, HID + (size_t)NLAT * DFF, nullptr, L, tid, lane, wave, bid, G);
#endif
        }
        SEAM(s0 + 7);
        if (IN(s0 + 8)) {
#ifndef NO_GEMM
            pg8::Gemm g{HID, (const bf16*)(ws + WS_W2 + l * SZ_W2), NLAT, DM, DFF}; pg8::StaticOrder S; S.init(NLAT, DM, G, bid);
            if (!last) { pg8::EpiResGateT<1, 1> E{X, X, modl + 10240}; pg8::gemm_phase<pg8::EpiResGateT<1, 1>, pg8::StaticOrder, false, true>(L, g, S, E); }
            else { pg8::EpiResGateT<1, 0> E{X, a.out, modl + 10240}; pg8::gemm_phase<pg8::EpiResGateT<1, 0>, pg8::StaticOrder, false, true>(L, g, S, E); }
            if (!last) sgemm_ctx<3>(HID + (size_t)NLAT * DFF, (const bf16*)(ws + WS_W2 + l * SZ_W2), DFF, DM, 4, nullptr, (float*)(ws + WS_PART), L, tid, lane, wave, bid, G);
#endif
        }
        SEAM(s0 + 8);
    }
__global__ void __launch_bounds__(NTHR, 2) mk_fwd(Args a) {
    __builtin_assume(__builtin_amdgcn_workitem_id_y() == 0); __builtin_assume(__builtin_amdgcn_workitem_id_z() == 0);
    extern __shared__ __attribute__((aligned(16))) unsigned char lds_raw[];
    LAS unsigned char* L = (LAS unsigned char*)lds_raw;
    const int lo = a.ph_lo, hi = a.ph_hi;
    if (threadIdx.x < 16) ((LAS unsigned*)(L + LDS_MISC))[threadIdx.x] = 0u;
    __syncthreads();
    if (blockIdx.x == 0) for (int i = threadIdx.x; i < 4096; i += NTHR) ((unsigned*)a.ws)[i] = 0u;
    cg::this_grid().sync();
    const XcdBarrier xbar = xcd_barrier_post((unsigned*)a.ws, (volatile LAS unsigned*)(L + LDS_MISC));
    if (IN(0)) {
#ifndef NO_P0
        const int tid = threadIdx.x;
        for (int rep = 0; rep < 1 + PROBE_P0; ++rep) { p0_phase(a, L, tid, tid & 63, __builtin_amdgcn_readfirstlane(tid >> 6), blockIdx.x, gridDim.x); __syncthreads(); }
#endif
    }
    if (IN(0) && IN(1)) xcd_barrier(xbar);
    layer_program<0>(a, L, lo, hi, xbar);
    layer_program<1>(a, L, lo, hi, xbar);
}
#undef IN
#undef SEAM

extern "C" void kernel_launch(void* const* d_in, const int* in_sizes, int n_in, void* d_out, int out_size, void* d_ws, size_t ws_size, hipStream_t stream) {
    static int grid = 0;
    if (grid == 0) {
        if (n_in != 20 || ws_size < WS_END) { fprintf(stderr, "kernel_launch: expected 20 inputs and >= %zu bytes of workspace (got %d, %zu)\n", (size_t)WS_END, n_in, ws_size); grid = -1; return; }
        int dev = 0, cus = 0, per_cu = 0;
        (void)hipGetDevice(&dev); (void)hipDeviceGetAttribute(&cus, hipDeviceAttributeMultiprocessorCount, dev);
        if (hipFuncSetAttribute((const void*)mk_fwd, hipFuncAttributeMaxDynamicSharedMemorySize, LDS_BYTES) != hipSuccess) { fprintf(stderr, "kernel_launch: hipFuncSetAttribute failed\n"); grid = -1; return; }
        if (hipOccupancyMaxActiveBlocksPerMultiprocessor(&per_cu, (const void*)mk_fwd, NTHR, LDS_BYTES) != hipSuccess || per_cu < 1) { fprintf(stderr, "kernel_launch: occupancy query gave %d\n", per_cu); per_cu = 1; }
        (void)hipGetLastError();
        grid = cus * per_cu;
        if (grid > 256) grid = 256;
    }
    if (grid < 0) return;
    Args a{};
    for (int i = 0; i < 20; ++i) a.in[i] = (const float*)d_in[i];
    a.out = (float*)d_out; a.ws = (unsigned char*)d_ws;
#if MK_ONE_LAUNCH
    a.ph_lo = 0; a.ph_hi = NSTEPS;
    void* args[] = {&a};
    hipError_t e = hipLaunchCooperativeKernel((const void*)mk_fwd, dim3(grid), dim3(NTHR), args, LDS_BYTES, stream);
    if (e != hipSuccess) fprintf(stderr, "kernel_launch: cooperative launch failed: %s (grid %d)\n", hipGetErrorString(e), grid);
#else
    for (int s = 0; s < NSTEPS; ++s) { a.ph_lo = s; a.ph_hi = s + 1; hipLaunchKernelGGL(mk_fwd, dim3(grid), dim3(NTHR), LDS_BYTES, stream, a); }
#endif
}
```

```cpp
#include <hip/hip_runtime.h>
#include <hip/hip_cooperative_groups.h>
#include <cstdio>
#include <cstdint>
namespace cg = cooperative_groups;
#ifndef MK_ONE_LAUNCH
#define MK_ONE_LAUNCH 1
#endif
namespace pg8 {
#define PG8_LAS __attribute__((address_space(3)))
typedef unsigned short bf16_t;
typedef short bf16x8 __attribute__((ext_vector_type(8)));
typedef float f32x4 __attribute__((ext_vector_type(4)));
typedef unsigned u32x4 __attribute__((ext_vector_type(4)));
constexpr int BM = 256, BK = 64, HALF = 128, HTB = HALF * BK * 2  , STAGE_BYTES = 8 * HTB, NXCD = 8, WGM = 8;

__host__ __device__ __forceinline__ int lds_byte(int r, int c) { const int st = (r >> 4) * 2 + (c >> 5), rr = r & 15, cc = c & 31, ob = rr * 64 + cc * 2; return st * 1024 + (ob ^ (((ob >> 9) & 1) << 5)); }
__host__ __device__ __forceinline__ void stage_rc(int b, int& R, int& C) { const int st = b / 1024, sb = b % 1024, swz = sb ^ (((sb >> 9) & 1) << 5); R = (st >> 1) * 16 + swz / 64; C = (st & 1) * 32 + (swz % 64) / 2; }
__host__ __device__ __forceinline__ int perm32(int rho) { const int n = rho >> 4, i = rho & 15; return 8 * (i >> 2) + 4 * n + (i & 3); }

struct Unit { int pm, pn; };
struct Gemm { const bf16_t* A; const bf16_t* Bt; int M, N, K; };

struct StaticOrder {
    int nM, nN, nwg, G, c;
    __host__ __device__ void init(int M, int N, int G_, int c_) { nM = M / BM; nN = N / BM; nwg = nM * nN; G = G_; c = c_; }
    __host__ __device__ bool next(int i, Unit& u) const {
        const long L = (long)i * G + c; if (L >= nwg) return false;
        int wgid = (int)L; { const int q = nwg / NXCD, r = nwg % NXCD, xcd = wgid % NXCD, off = wgid / NXCD; wgid = (xcd < r ? xcd * (q + 1) : r * (q + 1) + (xcd - r) * q) + off; }
        const int nig = WGM * nN, gid = wgid / nig, fm = gid * WGM, gsz = (nM - fm) < WGM ? (nM - fm) : WGM;
        u.pm = fm + ((wgid % nig) % gsz); u.pn = (wgid % nig) / gsz; return true;
    }
    __device__ __forceinline__ void a_ready(const Unit&) const {}
    __device__ __forceinline__ void done(const Unit&) const {}
};

__device__ __forceinline__ unsigned cvt_pk_bf16(float lo, float hi) { unsigned r; asm volatile("v_cvt_pk_bf16_f32 %0, %1, %2" : "=v"(r) : "v"(lo), "v"(hi)); return r; }
template <int ACT  > struct EpiStoreBf16 {
    static constexpr bool PERM = true, AFTER_DRAIN = false;
    bf16_t* O; int ldc;
    __device__ __forceinline__ void operator()(const f32x4 (&acc)[2][2][4][2], const Unit& u, int wr, int wc, int fr, int fq) const {
        asm volatile("s_nop 7\n\ts_nop 7\n\ts_nop 7" ::: "memory");
        const int row0 = u.pm * BM + wr * 64 + fr; const int col0 = u.pn * BM + wc * 32 + 8 * fq;
#pragma unroll
        for (int ai = 0; ai < 2; ++ai)
#pragma unroll
            for (int m = 0; m < 4; ++m) { bf16_t* rowp = O + (size_t)(row0 + ai * HALF + m * 16) * ldc + col0;
#pragma unroll
                for (int bj = 0; bj < 2; ++bj) { f32x4 v0 = acc[ai][bj][m][0], v1 = acc[ai][bj][m][1];
                    if (ACT == 2) {
#pragma unroll
                        for (int e = 0; e < 4; ++e) { float a0 = v0[e] > 0.f ? v0[e] : 0.f, a1 = v1[e] > 0.f ? v1[e] : 0.f; v0[e] = a0 * a0; v1[e] = a1 * a1; } }
                    u32x4 w; w.x = cvt_pk_bf16(v0[0], v0[1]); w.y = cvt_pk_bf16(v0[2], v0[3]); w.z = cvt_pk_bf16(v1[0], v1[1]); w.w = cvt_pk_bf16(v1[2], v1[3]);
                    *(u32x4*)(rowp + bj * HALF) = w; } }
    }
};
template <int RT, int OT> struct EpiResGateT {
    static constexpr bool PERM = true, AFTER_DRAIN = false;
    const void* res; void* out; const float* gate;
    static __device__ __forceinline__ f32x4 lo4(const u32x4& w) { f32x4 r; r.x = __builtin_bit_cast(float, w.x << 16); r.y = __builtin_bit_cast(float, w.x & 0xffff0000u); r.z = __builtin_bit_cast(float, w.y << 16); r.w = __builtin_bit_cast(float, w.y & 0xffff0000u); return r; }
    static __device__ __forceinline__ f32x4 hi4(const u32x4& w) { f32x4 r; r.x = __builtin_bit_cast(float, w.z << 16); r.y = __builtin_bit_cast(float, w.z & 0xffff0000u); r.z = __builtin_bit_cast(float, w.w << 16); r.w = __builtin_bit_cast(float, w.w & 0xffff0000u); return r; }
    __device__ __forceinline__ void operator()(const f32x4 (&acc)[2][2][4][2], const Unit& u, int wr, int wc, int fr, int fq) const {
        const int rt = u.pm * BM; const float* g = gate + (rt >> 12) * 12288;
        const int lr0 = rt + wr * 64 + fr, col0 = u.pn * BM + wc * 32 + 8 * fq;
#pragma unroll
        for (int bj = 0; bj < 2; ++bj) {
            const f32x4 gv0 = *(const f32x4*)(g + col0 + bj * HALF), gv1 = *(const f32x4*)(g + col0 + bj * HALF + 4);
            if (RT == 1) {
                u32x4 rw[2][4];
#pragma unroll
                for (int ai = 0; ai < 2; ++ai)
#pragma unroll
                    for (int m = 0; m < 4; ++m) rw[ai][m] = *(const u32x4*)((const bf16_t*)res + (size_t)(lr0 + ai * HALF + m * 16) * 2048 + col0 + bj * HALF);
#pragma unroll
                for (int ai = 0; ai < 2; ++ai)
#pragma unroll
                    for (int m = 0; m < 4; ++m) { const size_t off = (size_t)(lr0 + ai * HALF + m * 16) * 2048 + col0 + bj * HALF;
                        const f32x4 v0 = lo4(rw[ai][m]) + gv0 * acc[ai][bj][m][0], v1 = hi4(rw[ai][m]) + gv1 * acc[ai][bj][m][1];
                        if (OT == 0) { float* op = (float*)out + off; *(f32x4*)op = v0; *(f32x4*)(op + 4) = v1; }
                        else { u32x4 w; w.x = cvt_pk_bf16(v0[0], v0[1]); w.y = cvt_pk_bf16(v0[2], v0[3]); w.z = cvt_pk_bf16(v1[0], v1[1]); w.w = cvt_pk_bf16(v1[2], v1[3]);
                            *(u32x4*)((bf16_t*)out + off) = w; } }
            } else {
#pragma unroll
                for (int ai = 0; ai < 2; ++ai) {
                    f32x4 r[4][2];
#pragma unroll
                    for (int m = 0; m < 4; ++m) { const float* rp = (const float*)res + (size_t)(lr0 + ai * HALF + m * 16) * 2048 + col0 + bj * HALF; r[m][0] = *(const f32x4*)rp; r[m][1] = *(const f32x4*)(rp + 4); }
#pragma unroll
                    for (int m = 0; m < 4; ++m) { const size_t off = (size_t)(lr0 + ai * HALF + m * 16) * 2048 + col0 + bj * HALF;
                        const f32x4 v0 = r[m][0] + gv0 * acc[ai][bj][m][0], v1 = r[m][1] + gv1 * acc[ai][bj][m][1];
                        if (OT == 0) { float* op = (float*)out + off; *(f32x4*)op = v0; *(f32x4*)(op + 4) = v1; }
                        else { u32x4 w; w.x = cvt_pk_bf16(v0[0], v0[1]); w.y = cvt_pk_bf16(v0[2], v0[3]); w.z = cvt_pk_bf16(v1[0], v1[1]); w.w = cvt_pk_bf16(v1[2], v1[3]);
                            *(u32x4*)((bf16_t*)out + off) = w; } }
                }
            }
        }
    }
};
template <class Epi, class Sched, bool ALIGN_EPI = false, bool SP2 = false>
__device__ __forceinline__ void gemm_phase(PG8_LAS unsigned char* lds, const Gemm g, const Sched& S, const Epi& E) {
    const int tid = threadIdx.x, wid = __builtin_amdgcn_readfirstlane(tid >> 6), lane = tid & 63, wr = wid >> 2, wc = wid & 3, fr = lane & 15, fq = lane >> 4;
    const int K = g.K, nt = K / BK;
    unsigned voffA[2], voffB[2];
#pragma unroll
    for (int i = 0; i < 2; ++i) { int R, C; stage_rc(tid * 16 + i * 8192, R, C); const int Rb = Epi::PERM ? ((R & ~31) + perm32(R & 31)) : R;
        voffA[i] = (unsigned)(R * K + C) * 2u; voffB[i] = (unsigned)(Rb * K + C) * 2u; }
    const size_t kstep = (size_t)(BK * 2);
    const size_t hstep = (size_t)HALF * K * 2;
    const size_t tstep = 2 * hstep;
    const unsigned ldsw = (unsigned)wid * 1024u;
    const int aoff = lds_byte(wr * 64 + fr, fq * 8), boff = lds_byte(wc * 32 + fr, fq * 8);
#define PG8_SA(b, h) (((b) * 2 + (h)) * HTB)
#define PG8_SB(b, h) ((4 + (b) * 2 + (h)) * HTB)
#define PG8_STAGE(bufoff, gbase, voff) do { _Pragma("unroll") for (int _i = 0; _i < 2; ++_i) \
        __builtin_amdgcn_global_load_lds((const unsigned*)((const char*)(gbase) + (voff)[_i]), (PG8_LAS unsigned*)(lds + (bufoff) + ldsw + _i * 8192), 16, 0, 0); } while (0)
#define PG8_LDA(dst, b, h) do { _Pragma("unroll") for (int m = 0; m < 4; ++m) _Pragma("unroll") for (int k = 0; k < 2; ++k) dst[m][k] = *(const PG8_LAS bf16x8*)(lds + PG8_SA(b, h) + aoff + m * 2048 + k * 1024); } while (0)
#define PG8_LDB(dst, b, h) do { _Pragma("unroll") for (int n = 0; n < 2; ++n) _Pragma("unroll") for (int k = 0; k < 2; ++k) dst[n][k] = *(const PG8_LAS bf16x8*)(lds + PG8_SB(b, h) + boff + n * 2048 + k * 1024); } while (0)
#define PG8_MMA(ai, bj, At, Bt) do { __builtin_amdgcn_s_setprio(1); _Pragma("unroll") for (int m = 0; m < 4; ++m) _Pragma("unroll") for (int n = 0; n < 2; ++n) _Pragma("unroll") for (int k = 0; k < 2; ++k) \
        acc[ai][bj][m][n] = __builtin_amdgcn_mfma_f32_16x16x32_bf16(Bt[n][k], At[m][k], acc[ai][bj][m][n], 0, 0, 0); __builtin_amdgcn_s_setprio(0); } while (0)
#define PG8_WAIT_V(n) asm volatile("s_waitcnt vmcnt(" #n ")" ::: "memory")
#define PG8_WAIT_L(n) asm volatile("s_waitcnt lgkmcnt(" #n ")" ::: "memory")
#define PG8_BAR __builtin_amdgcn_s_barrier()
#define PG8_SCHED __builtin_amdgcn_sched_barrier(0)
    Unit cur, nxt; int ui = 0;
    if (!S.next(0, cur)) return;
    f32x4 acc[2][2][4][2];
#pragma unroll
    for (int a = 0; a < 2; ++a)
#pragma unroll
        for (int b = 0; b < 2; ++b)
#pragma unroll
            for (int m = 0; m < 4; ++m)
#pragma unroll
                for (int n = 0; n < 2; ++n) acc[a][b][m][n] = (f32x4){0.f, 0.f, 0.f, 0.f};
    bf16x8 At[4][2], B0[2][2], B1[2][2];
    const char* cA = (const char*)g.A + (size_t)cur.pm * tstep; const char* cB = (const char*)g.Bt + (size_t)cur.pn * tstep;
    S.a_ready(cur);
    if constexpr (SP2) {
        PG8_STAGE(PG8_SB(0, 0), cB, voffB); PG8_STAGE(PG8_SB(0, 1), cB + hstep, voffB); PG8_STAGE(PG8_SA(0, 0), cA, voffA); PG8_STAGE(PG8_SA(0, 1), cA + hstep, voffA);
        if (wr == 1) PG8_BAR;
        PG8_WAIT_V(2); PG8_BAR;
        PG8_STAGE(PG8_SB(1, 0), cB + kstep, voffB); PG8_STAGE(PG8_SA(1, 0), cA + kstep, voffA); PG8_STAGE(PG8_SB(1, 1), cB + hstep + kstep, voffB);
        PG8_WAIT_V(6); PG8_BAR;
    } else {
        PG8_STAGE(PG8_SB(0, 0), cB, voffB); PG8_STAGE(PG8_SA(0, 0), cA, voffA); PG8_STAGE(PG8_SB(0, 1), cB + hstep, voffB); PG8_STAGE(PG8_SA(0, 1), cA + hstep, voffA);
        if (wr == 1) PG8_BAR;
        PG8_WAIT_V(4); PG8_BAR;
        PG8_STAGE(PG8_SB(1, 0), cB + kstep, voffB); PG8_STAGE(PG8_SA(1, 0), cA + kstep, voffA); PG8_STAGE(PG8_SB(1, 1), cB + hstep + kstep, voffB);
        PG8_WAIT_V(6); PG8_BAR;
    }
    for (;;) {
        const bool has_next = S.next(ui + 1, nxt);
        const char* nA = has_next ? (const char*)g.A + (size_t)nxt.pm * tstep : cA; const char* nB = has_next ? (const char*)g.Bt + (size_t)nxt.pn * tstep : cB;
        for (int t = 0; t < nt; t += 2) {
            const bool last = (t == nt - 2);
            const char* a1 = cA + (size_t)(t + 1) * kstep;
            const char* a2 = last ? nA : cA + (size_t)(t + 2) * kstep; const char* b2 = last ? nB : cB + (size_t)(t + 2) * kstep;
            const char* a3 = a2 + kstep; const char* b3 = b2 + kstep;
            if (last && has_next) S.a_ready(nxt);
            if constexpr (SP2) {
            PG8_LDB(B0, 0, 0); PG8_LDB(B1, 0, 1); PG8_SCHED; PG8_LDA(At, 0, 0); PG8_STAGE(PG8_SA(1, 1), a1 + hstep, voffA);
            PG8_WAIT_V(8); PG8_WAIT_L(0); PG8_BAR; PG8_MMA(0, 0, At, B0); PG8_MMA(0, 1, At, B1); PG8_BAR; PG8_SCHED;
            PG8_LDA(At, 0, 1); PG8_STAGE(PG8_SB(0, 0), b2, voffB); PG8_STAGE(PG8_SB(0, 1), b2 + hstep, voffB); PG8_STAGE(PG8_SA(0, 0), a2, voffA);
            PG8_WAIT_V(8); PG8_WAIT_L(0); PG8_BAR; PG8_MMA(1, 0, At, B0); PG8_MMA(1, 1, At, B1); PG8_BAR; PG8_SCHED;
            PG8_LDB(B0, 1, 0); PG8_LDB(B1, 1, 1); PG8_SCHED; PG8_LDA(At, 1, 0); PG8_STAGE(PG8_SA(0, 1), a2 + hstep, voffA);
            PG8_WAIT_V(8); PG8_WAIT_L(0); PG8_BAR; PG8_MMA(0, 0, At, B0); PG8_MMA(0, 1, At, B1); PG8_BAR; PG8_SCHED;
            PG8_LDA(At, 1, 1); PG8_STAGE(PG8_SB(1, 0), b3, voffB); PG8_STAGE(PG8_SB(1, 1), b3 + hstep, voffB); PG8_STAGE(PG8_SA(1, 0), a3, voffA);
            PG8_WAIT_V(8); PG8_WAIT_L(0); PG8_BAR; PG8_MMA(1, 0, At, B0); PG8_MMA(1, 1, At, B1); PG8_BAR; PG8_SCHED;
            } else {
            PG8_LDB(B0, 0, 0); PG8_SCHED; PG8_LDA(At, 0, 0); PG8_STAGE(PG8_SA(1, 1), a1 + hstep, voffA);
            PG8_WAIT_L(8); PG8_BAR; PG8_WAIT_L(0); PG8_MMA(0, 0, At, B0); PG8_BAR; PG8_SCHED;
            PG8_LDB(B1, 0, 1); PG8_STAGE(PG8_SB(0, 0), b2, voffB);
            PG8_BAR; PG8_WAIT_L(0); PG8_MMA(0, 1, At, B1); PG8_BAR;
            PG8_LDA(At, 0, 1); PG8_STAGE(PG8_SA(0, 0), a2, voffA);
            PG8_BAR; PG8_WAIT_L(0); PG8_MMA(1, 0, At, B0); PG8_BAR; PG8_SCHED;
            PG8_STAGE(PG8_SB(0, 1), b2 + hstep, voffB);
            PG8_WAIT_V(6); PG8_BAR; PG8_MMA(1, 1, At, B1); PG8_BAR;
            PG8_LDB(B0, 1, 0); PG8_SCHED; PG8_LDA(At, 1, 0); PG8_STAGE(PG8_SA(0, 1), a2 + hstep, voffA);
            PG8_WAIT_L(8); PG8_BAR; PG8_WAIT_L(0); PG8_MMA(0, 0, At, B0); PG8_BAR; PG8_SCHED;
            PG8_LDB(B1, 1, 1); PG8_STAGE(PG8_SB(1, 0), b3, voffB);
            PG8_BAR; PG8_WAIT_L(0); PG8_MMA(0, 1, At, B1); PG8_BAR;
            PG8_LDA(At, 1, 1); PG8_STAGE(PG8_SA(1, 0), a3, voffA);
            PG8_BAR; PG8_WAIT_L(0); PG8_MMA(1, 0, At, B0); PG8_BAR; PG8_SCHED;
            PG8_STAGE(PG8_SB(1, 1), b3 + hstep, voffB);
            PG8_WAIT_V(6); PG8_BAR; PG8_MMA(1, 1, At, B1); PG8_BAR;
            }
        }
        if constexpr (ALIGN_EPI) { if (wr == 0) PG8_BAR; }
        if constexpr (!Epi::AFTER_DRAIN) { E(acc, cur, wr, wc, fr, fq); S.done(cur); }
        if (!has_next) break;
#pragma unroll
        for (int a = 0; a < 2; ++a)
#pragma unroll
            for (int b = 0; b < 2; ++b)
#pragma unroll
                for (int m = 0; m < 4; ++m)
#pragma unroll
                    for (int n = 0; n < 2; ++n) acc[a][b][m][n] = (f32x4){0.f, 0.f, 0.f, 0.f};
        cur = nxt; cA = nA; cB = nB; ++ui;
        if constexpr (ALIGN_EPI) { if (wr == 1) PG8_BAR; }
    }
    PG8_WAIT_V(0);
    if constexpr (!ALIGN_EPI) { if (wr == 0) PG8_BAR; }
    PG8_BAR;
    if constexpr (Epi::AFTER_DRAIN) { E.fused(acc, cur, wr, wc, fr, fq, lds, wid, lane); S.done(cur); }
#undef PG8_SA
#undef PG8_SB
#undef PG8_STAGE
#undef PG8_LDA
#undef PG8_LDB
#undef PG8_MMA
#undef PG8_WAIT_V
#undef PG8_WAIT_L
#undef PG8_BAR
#undef PG8_SCHED
}
}

#define LAS __attribute__((address_space(3)))
typedef unsigned short bf16;
typedef short bf16x8 __attribute__((ext_vector_type(8)));
typedef float f32x4 __attribute__((ext_vector_type(4)));
typedef float f32x2 __attribute__((ext_vector_type(2)));
typedef unsigned u32x4 __attribute__((ext_vector_type(4)));
typedef unsigned u32x2 __attribute__((ext_vector_type(2)));

constexpr int NTHR = 512;
constexpr int DM = 2048, SEQ = 4096, CTX = 256, NLAT = 8192, MTOK = 8704, DFF = 8192;
constexpr int INC = 7200, LDP = 7424;
constexpr int NSC = 68;
constexpr int C_GQ = 0, C_GK = 256, C_GV = 512, C_GR = 1024, C_GA = 1536;
constexpr int C_HQ = 1568, C_HF = 2080, C_HI = 3104, C_HG = 3616;
constexpr int C_NQ = 4128, C_NK = 5152, C_NV = 6176;
constexpr size_t MiB = 1u << 20;
constexpr size_t WS_MOD = 1 * MiB;
constexpr size_t WS_ROPE = 1 * MiB + 512 * 1024;
constexpr size_t WS_WIN = 2 * MiB, SZ_WIN = 29 * MiB;
constexpr size_t WS_WOUT = WS_WIN + 2 * SZ_WIN, SZ_WOUT = 8 * MiB;
constexpr size_t WS_W1 = WS_WOUT + 2 * SZ_WOUT, SZ_W1 = 32 * MiB;
constexpr size_t WS_W2 = WS_W1 + 2 * SZ_W1, SZ_W2 = 32 * MiB;
constexpr size_t WS_H = WS_W2 + 2 * SZ_W2;
constexpr size_t WS_Y = WS_H + 34 * MiB;
constexpr size_t WS_X = WS_Y + 34 * MiB;
constexpr size_t WS_U = WS_X + 68 * MiB;
constexpr size_t WS_P = WS_U, WS_HID = WS_U;
constexpr size_t WS_STG = WS_U + 124 * MiB;
constexpr size_t WS_STH = WS_STG + 34 * MiB;
constexpr size_t WS_DCG = WS_STH + 68 * MiB;
constexpr size_t WS_DCH = WS_DCG + 1 * MiB;
constexpr size_t WS_SBG = WS_DCH + 1 * MiB;
constexpr size_t WS_SBH = WS_SBG + 17 * MiB;
constexpr size_t WS_PART = WS_SBH + 34 * MiB;
constexpr size_t WS_END = WS_PART + 16 * MiB;
constexpr int LDS_BYTES = 147456, LDS_MISC = 147328;
constexpr size_t CTL_ZERO_BYTES = 65536;

struct Args { const float* in[20]; float* out; unsigned char* ws; int ph_lo, ph_hi; };

__device__ __forceinline__ unsigned f2bf(float f) { unsigned u = __builtin_bit_cast(unsigned, f); return (u + 0x7fffu + ((u >> 16) & 1u)) >> 16; }
__device__ __forceinline__ unsigned pk2(float lo, float hi) { return f2bf(lo) | (f2bf(hi) << 16); }
__device__ __forceinline__ float bf2f(unsigned h) { return __builtin_bit_cast(float, h << 16); }
__device__ __forceinline__ float wave_sum(float v) {
#pragma unroll
    for (int o = 1; o < 64; o <<= 1) v += __shfl_xor(v, o);
    return v;
}
__device__ __forceinline__ float wave_max(float v) {
#pragma unroll
    for (int o = 1; o < 64; o <<= 1) v = fmaxf(v, __shfl_xor(v, o));
    return v;
}
__device__ __forceinline__ float sigmoid_f(float x) { return 1.f / (1.f + __expf(-x)); }
__device__ __forceinline__ float silu_f(float x) { return x / (1.f + __expf(-x)); }
__device__ __forceinline__ float logsig_f(float x) { return fminf(x, 0.f) - __logf(1.f + __expf(-fabsf(x))); }
__device__ __forceinline__ bf16x8 frag(const LAS bf16* base, int ld, int row0, int k0, int lane) {
    return *(const LAS bf16x8*)(base + (row0 + (lane & 15)) * ld + k0 + (lane >> 4) * 8);
}
#define MFMA16(a, b, c) __builtin_amdgcn_mfma_f32_16x16x32_bf16((a), (b), (c), 0, 0, 0)

__device__ __forceinline__ void p0_transpose_item(const float* W, int K, int N, bf16* WT, LAS float* scr, int item, int lane) {
    const int nblk = N / 32, kb = item / nblk, nb = item % nblk, k0 = 64 * kb, n0 = 32 * nb;
    const int r8 = lane >> 3, c4 = (lane & 7) * 4;
    f32x4 v[8];
#pragma unroll
    for (int i = 0; i < 8; ++i) v[i] = *(const f32x4*)(W + (size_t)(k0 + 8 * i + r8) * N + n0 + c4);
#pragma unroll
    for (int i = 0; i < 8; ++i) { LAS float* d = scr + (8 * i + r8) * 33 + c4; d[0] = v[i].x; d[1] = v[i].y; d[2] = v[i].z; d[3] = v[i].w; }
    asm volatile("s_waitcnt lgkmcnt(0)" ::: "memory");
    const int c = lane & 7;
#pragma unroll
    for (int j = 0; j < 4; ++j) { const int n = (lane >> 3) + 8 * j; const LAS float* s = scr + (8 * c) * 33 + n;
        u32x4 o; o.x = pk2(s[0 * 33], s[1 * 33]); o.y = pk2(s[2 * 33], s[3 * 33]); o.z = pk2(s[4 * 33], s[5 * 33]); o.w = pk2(s[6 * 33], s[7 * 33]);
        *(u32x4*)(WT + (size_t)(n0 + n) * K + k0 + 8 * c) = o; }
    asm volatile("s_waitcnt lgkmcnt(0)" ::: "memory");
}

__device__ __forceinline__ void p0_phase(const Args& a, LAS unsigned char* L, int tid, int lane, int wave, int bid, int G) {
    unsigned char* ws = a.ws;
    float* MOD = (float*)(ws + WS_MOD);
    {
        LAS float* sv = (LAS float*)L;
        LAS float* red = (LAS float*)(L + 24576);
        for (int i = tid; i < 3 * 2048; i += NTHR) { const int s = i >> 11, k = i & 2047; const float c = s < 2 ? a.in[1][s * 2048 + k] : a.in[3][k]; sv[i] = silu_f(c); }
        __syncthreads();
        for (int it = bid; it < 256; it += G) {
            const int l = it >> 7, n0 = (it & 127) * 96;
            const float* W = a.in[4] + (size_t)l * 2048 * 12288 + n0;
            const int cgp = tid % 24, rg = tid / 24;
            float acc[3][4];
#pragma unroll
            for (int s = 0; s < 3; ++s)
#pragma unroll
                for (int j = 0; j < 4; ++j) acc[s][j] = 0.f;
            if (rg < 21) {
#pragma unroll 8
                for (int k = rg; k < 2048; k += 21) {
                    const f32x4 w = *(const f32x4*)(W + (size_t)k * 12288 + cgp * 4);
                    const float s0 = sv[k], s1 = sv[2048 + k], s2 = sv[4096 + k];
#pragma unroll
                    for (int j = 0; j < 4; ++j) { acc[0][j] += s0 * w[j]; acc[1][j] += s1 * w[j]; acc[2][j] += s2 * w[j]; }
                }
#pragma unroll
                for (int s = 0; s < 3; ++s)
#pragma unroll
                    for (int j = 0; j < 4; ++j) red[(rg * 3 + s) * 96 + cgp * 4 + j] = acc[s][j];
            }
            __syncthreads();
            if (tid < 288) { const int s = tid / 96, ci = tid % 96; float t = 0.f;
                for (int r2 = 0; r2 < 21; ++r2) t += red[(r2 * 3 + s) * 96 + ci];
                MOD[(size_t)(l * 3 + s) * 12288 + n0 + ci] = t + a.in[5][l * 12288 + n0 + ci]; }
            __syncthreads();
        }
    }
    if (bid == 0) {
        for (int u = tid; u < 1024; u += NTHR) { const int pos = u >> 4, i = u & 15;
            const float inv = (float)exp2(-(double)i * (13.287712379549449 / 16.0));
            const double ang = (double)pos * (double)inv;
            const double kq = rint(ang * 0.15915494309189535);
            const float rr = (float)(ang - kq * 6.283185307179586);
            f32x2 cs; cs.x = cosf(rr); cs.y = sinf(rr);
            ((f32x2*)(ws + WS_ROPE))[u] = cs; }
    }
    {
        LAS float* scr = (LAS float*)(L + wave * 16384);
        const int gw = bid * 8 + wave, NGW = G * 8;
        constexpr int I_IN = 32 * 225, I_OUT = 32 * 64, I_1 = 32 * 256, I_2 = 128 * 64, I_L = I_IN + I_OUT + I_1 + I_2;
        for (int it = gw; it < 2 * I_L; it += NGW) {
            const int l = it / I_L; int r = it % I_L;
            if (r < I_IN) { p0_transpose_item(a.in[7] + (size_t)l * DM * INC, DM, INC, (bf16*)(ws + WS_WIN + l * SZ_WIN), scr, r, lane); continue; } r -= I_IN;
            if (r < I_OUT) { p0_transpose_item(a.in[16] + (size_t)l * DM * DM, DM, DM, (bf16*)(ws + WS_WOUT + l * SZ_WOUT), scr, r, lane); continue; } r -= I_OUT;
            if (r < I_1) { p0_transpose_item(a.in[18] + (size_t)l * DM * DFF, DM, DFF, (bf16*)(ws + WS_W1 + l * SZ_W1), scr, r, lane); continue; } r -= I_1;
            p0_transpose_item(a.in[19] + (size_t)l * DFF * DM, DFF, DM, (bf16*)(ws + WS_W2 + l * SZ_W2), scr, r, lane);
        }
    }
}

template <int LT, int CT>
__device__ __forceinline__ void norm_load_row(const void* xlat, const void* xctx, int row, int lane, f32x4* v) {
    const bool isl = row < NLAT;
#pragma unroll
    for (int j = 0; j < 8; ++j) { const int c4 = lane + 64 * j;
        if (isl) { if (LT == 0) v[j] = ((const f32x4*)((const float*)xlat + (size_t)row * DM))[c4];
                   else { const u32x2 w = ((const u32x2*)((const bf16*)xlat + (size_t)row * DM))[c4]; v[j] = (f32x4){bf2f(w.x & 0xffffu), bf2f(w.x >> 16), bf2f(w.y & 0xffffu), bf2f(w.y >> 16)}; } }
        else { if (CT == 0) v[j] = ((const f32x4*)((const float*)xctx + (size_t)(row - NLAT) * DM))[c4];
               else { const u32x2 w = ((const u32x2*)((const bf16*)xctx + (size_t)(row - NLAT) * DM))[c4]; v[j] = (f32x4){bf2f(w.x & 0xffffu), bf2f(w.x >> 16), bf2f(w.y & 0xffffu), bf2f(w.y >> 16)}; } } }
}
template <int LT, int CT>
__device__ __forceinline__ void norm_phase(const void* xlat, const void* xctx, int nrows, const float* g, const float* modl, int sh_off, int sc_off, bf16* H, int lane, int gw, int NGW,
                                           const float* part = nullptr, const float* pgate = nullptr, bf16* xfin = nullptr) {
    f32x4 v[8], vn[8];
    if (gw < nrows) norm_load_row<LT, CT>(xlat, xctx, gw, lane, v);
    for (int row = gw; row < nrows; row += NGW) {
        if (row + NGW < nrows) norm_load_row<LT, CT>(xlat, xctx, row + NGW, lane, vn);
        const bool isl = row < NLAT;
        const int sg = isl ? (row >> 12) : 2;
        const float* sh = modl + sg * 12288 + sh_off; const float* sc = modl + sg * 12288 + sc_off;
        float ss = 0.f;
#pragma unroll
        for (int j = 0; j < 8; ++j) { const int c4 = lane + 64 * j;
            if (part != nullptr && !isl) {
                const size_t po = (size_t)(row - NLAT) * DM + c4 * 4;
                const f32x4 p0 = *(const f32x4*)(part + po), p1 = *(const f32x4*)(part + po + (size_t)512 * DM), p2 = *(const f32x4*)(part + po + (size_t)1024 * DM), p3 = *(const f32x4*)(part + po + (size_t)1536 * DM);
                v[j] = v[j] + ((const f32x4*)pgate)[c4] * ((p0 + p1) + (p2 + p3));
                u32x2 w; w.x = pk2(v[j].x, v[j].y); w.y = pk2(v[j].z, v[j].w); *(u32x2*)(xfin + po) = w; }
            ss += (v[j].x * v[j].x + v[j].y * v[j].y) + (v[j].z * v[j].z + v[j].w * v[j].w); }
        const float rstd = rsqrtf(wave_sum(ss) * (1.f / DM) + 1e-6f);
        u32x2* o8 = (u32x2*)(H + (size_t)row * DM);
#pragma unroll
        for (int j = 0; j < 8; ++j) { const int c4 = lane + 64 * j; const f32x4 g4 = ((const f32x4*)g)[c4], s4 = ((const f32x4*)sc)[c4], h4 = ((const f32x4*)sh)[c4];
            const f32x4 o = v[j] * rstd * g4 * (s4 + 1.f) + h4;
            u32x2 w; w.x = pk2(o.x, o.y); w.y = pk2(o.z, o.w); o8[c4] = w; }
#pragma unroll
        for (int j = 0; j < 8; ++j) v[j] = vn[j];
    }
}

typedef short s16x4 __attribute__((ext_vector_type(4)));
__device__ __forceinline__ bf16x8 frag_tr(const LAS bf16* base, int ld, int k0, int n0, int lane) {
    const int i = lane & 15;
    const LAS bf16* p = base + (k0 + (lane >> 4) * 8 + (i >> 2)) * ld + n0 + 4 * (i & 3);
    const s16x4 lo = __builtin_amdgcn_ds_read_tr16_b64_v4i16((LAS s16x4*)p);
    const s16x4 hi = __builtin_amdgcn_ds_read_tr16_b64_v4i16((LAS s16x4*)(p + 4 * ld));
    return (bf16x8){lo[0], lo[1], lo[2], lo[3], hi[0], hi[1], hi[2], hi[3]};
}
__device__ __forceinline__ float bfe(const u32x4& w, int e) { const unsigned x = w[e >> 1]; return __builtin_bit_cast(float, (e & 1) ? (x & 0xffff0000u) : (x << 16)); }
__device__ __forceinline__ unsigned cvtpk(float lo, float hi) { unsigned r; asm volatile("s_nop 1\n\tv_cvt_pk_bf16_f32 %0, %1, %2" : "=v"(r) : "v"(lo), "v"(hi)); return r; }
__device__ __forceinline__ u32x4 pack8(const float* v) { u32x4 w; w.x = cvtpk(v[0], v[1]); w.y = cvtpk(v[2], v[3]); w.z = cvtpk(v[4], v[5]); w.w = cvtpk(v[6], v[7]); return w; }

__device__ __forceinline__ void qknorm_pass(const Args& a, int l, bf16* P, int lane, int gw, int NGW) {
    const int sub = lane >> 4, li = lane & 15;
    const float* qn = a.in[13] + l * 128 + li * 8; const float* kn = a.in[14] + l * 128 + li * 8;
    float wq[8], wk[8];
#pragma unroll
    for (int e = 0; e < 8; ++e) { wq[e] = qn[e] * 0.08838834764831845f; wk[e] = kn[e]; }
#pragma unroll 2
    for (int u = gw * 4 + sub; u < MTOK * 16; u += NGW * 4) { const int row = u >> 4, hq = u & 15, isk = hq >> 3, h = hq & 7;
        bf16* p = P + (size_t)row * LDP + (isk ? C_NK : C_NQ) + h * 128 + li * 8;
        const u32x4 w = *(const u32x4*)p;
        float x[8], ss = 0.f;
#pragma unroll
        for (int e = 0; e < 8; ++e) { x[e] = bfe(w, e); ss += x[e] * x[e]; }
        ss += __shfl_xor(ss, 1); ss += __shfl_xor(ss, 2); ss += __shfl_xor(ss, 4); ss += __shfl_xor(ss, 8);
        const float rstd = rsqrtf(ss * (1.f / 128.f) + 1e-6f);
#pragma unroll
        for (int e = 0; e < 8; ++e) x[e] = x[e] * rstd * (isk ? wk[e] : wq[e]);
        *(u32x4*)p = pack8(x); }
}

__device__ __forceinline__ u32x4 norm8(const u32x4& w, const float* wt) {
    float x[8], ss = 0.f;
#pragma unroll
    for (int e = 0; e < 8; ++e) { x[e] = bfe(w, e); ss += x[e] * x[e]; }
    ss += __shfl_xor(ss, 1); ss += __shfl_xor(ss, 2); ss += __shfl_xor(ss, 4); ss += __shfl_xor(ss, 8);
    const float rstd = rsqrtf(ss * (1.f / 128.f) + 1e-6f);
#pragma unroll
    for (int e = 0; e < 8; ++e) x[e] = x[e] * rstd * wt[e];
    return pack8(x);
}
__device__ __forceinline__ void na_band(const Args& a, int l, const bf16* P, bf16* Y, int b, int h, int rbase, int nwin, LAS unsigned char* L, int tid, int lane, int wave) {
    asm volatile("" : "+v"(tid), "+v"(lane), "+s"(wave));
    LAS bf16* QN = (LAS bf16*)L;
    LAS bf16* KB = (LAS bf16*)(L + 69632);
    LAS bf16* VB = KB + 8704;
    LAS bf16* PB = (LAS bf16*)(L + 104448);
    LAS float* LS = (LAS float*)(L + 141312);
    LAS float* RB = (LAS float*)(L + 143360);
    LAS float* MISC = (LAS float*)(L + 145408);
    const float* rpb = a.in[15] + (size_t)(l * 8 + h) * 465;
    {
        const float rv = tid < 465 ? rpb[tid] : 0.f, qv = tid < 128 ? a.in[13][l * 128 + tid] : 0.f, kv = tid < 128 ? a.in[14][l * 128 + tid] : 0.f;
        if (tid < 465) RB[tid] = rv;
        const float m3 = wave_max(fabsf(rv)), m1 = wave_max(fabsf(qv)), m2 = wave_max(fabsf(kv));
        if (lane == 0) { MISC[1 + wave] = m3; MISC[9 + wave] = m1; MISC[17 + wave] = m2; }
    }
    const int uj = tid >> 4, uc = (tid & 15) * 8;
    const bf16* Ph = P + h * 128 + uc;
    float wq[8], wk[8];
#pragma unroll
    for (int e = 0; e < 8; ++e) { wq[e] = a.in[13][l * 128 + uc + e] * 0.08838834764831845f; wk[e] = a.in[14][l * 128 + uc + e]; }
    const int qrow0 = nwin ? b * SEQ + rbase * 64 : NLAT + b * CTX;
#pragma unroll
    for (int qb = 0; qb < 4; ++qb)
#pragma unroll
        for (int t = 0; t < 2; ++t) *(LAS u32x4*)(QN + qb * 8704 + (uj + 32 * t) * 136 + uc) = norm8(*(const u32x4*)(Ph + (size_t)(qrow0 + qb * 64 + uj + 32 * t) * LDP + C_NQ), wq);
    const int rlo = rbase - 4 < 0 ? 0 : (rbase - 4 > 56 ? 56 : rbase - 4), rhi3 = rbase - 1 < 0 ? 0 : (rbase - 1 > 56 ? 56 : rbase - 1);
    const int ntw = nwin ? (rhi3 + 8 - rlo) : 0, nt = ntw + 4;
    u32x4 rk[2], rv[2];
#define NA_LOADT(ti_) do { const int kr_ = (ti_) < ntw ? b * SEQ + (rlo + (ti_)) * 64 : NLAT + b * CTX + ((ti_) - ntw) * 64; \
        _Pragma("unroll") for (int t = 0; t < 2; ++t) { const bf16* pp_ = Ph + (size_t)(kr_ + uj + 32 * t) * LDP; rk[t] = *(const u32x4*)(pp_ + C_NK); rv[t] = *(const u32x4*)(pp_ + C_NV); } } while (0)
    NA_LOADT(0);
    const int qt = wave & 3, wg2 = wave >> 2, quad = lane >> 4, l15 = lane & 15;
    f32x4 o[4][4]; float lsum[4];
#pragma unroll
    for (int qb = 0; qb < 4; ++qb) { lsum[qb] = 0.f;
#pragma unroll
        for (int t = 0; t < 4; ++t) o[qb][t] = (f32x4){0.f, 0.f, 0.f, 0.f}; }
    const int qq = qt * 16 + l15, csq = qq - 8 < 0 ? 0 : (qq - 8 > 48 ? 48 : qq - 8);
    unsigned wmask = 0u;
#pragma unroll
    for (int t2 = 0; t2 < 2; ++t2)
#pragma unroll
        for (int jj = 0; jj < 4; ++jj) { const int kc = (wg2 * 2 + t2) * 16 + quad * 4 + jj; if (kc >= csq && kc < csq + 16) wmask |= 1u << (t2 * 4 + jj); }
    const int dcb = wg2 * 32 + quad * 4 - qq + 15;
    float shift = 0.f;
#pragma unroll 1
    for (int ti = 0; ti < nt; ++ti) {
        __syncthreads();
#pragma unroll
        for (int t = 0; t < 2; ++t) { *(LAS u32x4*)(KB + (uj + 32 * t) * 136 + uc) = norm8(rk[t], wk); *(LAS u32x4*)(VB + (uj + 32 * t) * 136 + uc) = rv[t]; }
        if (ti + 1 < nt) NA_LOADT(ti + 1);
        __syncthreads();
        { float m3 = 0.f, m1 = 0.f, m2 = 0.f;
#pragma unroll
          for (int w8 = 0; w8 < 8; ++w8) { m3 = fmaxf(m3, MISC[1 + w8]); m1 = fmaxf(m1, MISC[9 + w8]); m2 = fmaxf(m2, MISC[17 + w8]); }
          shift = 11.313708499f * m1 * m2 + m3; }
        const int kr = rlo + ti;
        const bool win = ti < ntw;
        const unsigned msk = win ? wmask : 0xffu;
        {
            bf16x8 kf[2][4];
#pragma unroll
            for (int t2 = 0; t2 < 2; ++t2)
#pragma unroll
                for (int ks = 0; ks < 4; ++ks) kf[t2][ks] = frag(KB, 136, (wg2 * 2 + t2) * 16, ks * 32, lane);
#pragma unroll
            for (int qb = 0; qb < 4; ++qb) {
                const int rq = rbase + qb, r0q = rq - 4 < 0 ? 0 : (rq - 4 > 56 ? 56 : rq - 4);
                const bool use = !win || (kr >= r0q && kr < r0q + 8);
                if (use) {
                    const LAS float* rbr = RB + (win ? (kr - rq + 7) * 31 : 0);
                    f32x4 sT[2];
                    sT[0] = (f32x4){0.f, 0.f, 0.f, 0.f}; sT[1] = (f32x4){0.f, 0.f, 0.f, 0.f};
#pragma unroll
                    for (int ks = 0; ks < 4; ++ks) { const bf16x8 qf = frag(QN + qb * 8704, 136, qt * 16, ks * 32, lane);
                        sT[0] = MFMA16(kf[0][ks], qf, sT[0]); sT[1] = MFMA16(kf[1][ks], qf, sT[1]); }
#pragma unroll
                    for (int t2 = 0; t2 < 2; ++t2) { const int ktile = wg2 * 2 + t2;
                        float pv[4];
#pragma unroll
                        for (int jj = 0; jj < 4; ++jj) { const bool valid = (msk >> (t2 * 4 + jj)) & 1u;
                            int bi = dcb + 16 * t2 + jj; bi = bi < 0 ? 0 : (bi > 30 ? 30 : bi);
                            const float bias = win ? rbr[bi] : 0.f;
                            pv[jj] = valid ? __expf(sT[t2][jj] + bias - shift) : 0.f; lsum[qb] += pv[jj]; }
                        u32x2 w; w.x = cvtpk(pv[0], pv[1]); w.y = cvtpk(pv[2], pv[3]);
                        *(LAS u32x2*)(PB + qb * 4608 + qq * 72 + ktile * 16 + quad * 4) = w; }
                }
            }
        }
        __syncthreads();
        {
            bf16x8 vf[2][4];
#pragma unroll
            for (int ks = 0; ks < 2; ++ks)
#pragma unroll
                for (int t = 0; t < 4; ++t) vf[ks][t] = frag_tr(VB, 136, ks * 32, (wg2 * 4 + t) * 16, lane);
#pragma unroll
            for (int qb = 0; qb < 4; ++qb) {
                const int rq = rbase + qb, r0q = rq - 4 < 0 ? 0 : (rq - 4 > 56 ? 56 : rq - 4);
                const bool use = !win || (kr >= r0q && kr < r0q + 8);
                if (use) {
#pragma unroll
                    for (int ks = 0; ks < 2; ++ks) { const bf16x8 af = frag(PB + qb * 4608, 72, qt * 16, ks * 32, lane);
#pragma unroll
                        for (int t = 0; t < 4; ++t) o[qb][t] = MFMA16(af, vf[ks][t], o[qb][t]); }
                }
            }
        }
    }
#undef NA_LOADT
#pragma unroll
    for (int qb = 0; qb < 4; ++qb) { float v = lsum[qb]; v += __shfl_xor(v, 16); v += __shfl_xor(v, 32);
        if (quad == 0) LS[qb * 128 + wg2 * 64 + qq] = v; }
    __syncthreads();
#pragma unroll
    for (int qb = 0; qb < 4; ++qb)
#pragma unroll
        for (int jj = 0; jj < 4; ++jj) { const int q = qt * 16 + quad * 4 + jj; const float inv = 1.f / (LS[qb * 128 + q] + LS[qb * 128 + 64 + q]);
            bf16* yr = Y + (size_t)(qrow0 + qb * 64 + q) * DM + 1024 + h * 128 + wg2 * 64 + l15;
#pragma unroll
            for (int t = 0; t < 4; ++t) yr[t * 16] = (bf16)f2bf(o[qb][t][jj] * inv); }
    __syncthreads();
}

template <int MX> __device__ __forceinline__ void load_unit(const Args& a, const bf16* prow, int h, int dg, int seg, int c, int jtok, int dir, bool need_q,
                                                              const float* lbv, const LAS float* W2L, float* q, float* k, float* g) {
    if (MX == 0) {
        const u32x4 a0 = *(const u32x4*)(prow + C_GA + dir * 16), a1 = *(const u32x4*)(prow + C_GA + dir * 16 + 8);
        float s[8];
#pragma unroll
        for (int e = 0; e < 8; ++e) s[e] = W2L[1024 + dg * 8 + e];
#pragma unroll
        for (int r = 0; r < 16; ++r) { const float al = r < 8 ? bfe(a0, r) : bfe(a1, r - 8);
            const f32x4 w0 = *(const LAS f32x4*)(W2L + r * 64 + dg * 8), w1 = *(const LAS f32x4*)(W2L + r * 64 + dg * 8 + 4);
#pragma unroll
            for (int e = 0; e < 4; ++e) { s[e] += al * w0[e]; s[4 + e] += al * w1[e]; }
            if ((r & 3) == 3) __builtin_amdgcn_sched_barrier(0); }
#pragma unroll
        for (int e = 0; e < 8; ++e) g[e] = logsig_f(s[e]) * (1.f / 16.f);
        const int odd = (dg >> 1) & 1, hf = dg >> 2, i0 = (dg & 1) * 8;
        float cs[8], sn[8];
        if (seg) { const f32x4* rp = (const f32x4*)((const f32x2*)(a.ws + WS_ROPE) + (hf ? jtok : c) * 16 + i0);
#pragma unroll
            for (int e2 = 0; e2 < 4; ++e2) { const f32x4 t = rp[e2]; cs[2 * e2] = t.x; sn[2 * e2] = t.y; cs[2 * e2 + 1] = t.z; sn[2 * e2 + 1] = t.w; } }
        else {
#pragma unroll
            for (int e = 0; e < 8; ++e) { cs[e] = 1.f; sn[e] = 0.f; } }
        { const u32x4 ow = *(const u32x4*)(prow + C_GK + h * 64 + dg * 8), pw = *(const u32x4*)(prow + C_GK + h * 64 + (dg ^ 2) * 8);
#pragma unroll
            for (int e = 0; e < 8; ++e) { const float own = bfe(ow, e), par = bfe(pw, e); k[e] = odd ? (par * sn[e] + own * cs[e]) : (own * cs[e] - par * sn[e]); } }
        if (need_q) { const u32x4 ow = *(const u32x4*)(prow + C_GQ + h * 64 + dg * 8), pw = *(const u32x4*)(prow + C_GQ + h * 64 + (dg ^ 2) * 8);
#pragma unroll
            for (int e = 0; e < 8; ++e) { const float own = bfe(ow, e) * 0.125f, par = bfe(pw, e) * 0.125f; q[e] = odd ? (par * sn[e] + own * cs[e]) : (own * cs[e] - par * sn[e]); } }
    } else {
        const u32x4 fw = *(const u32x4*)(prow + C_HF + dir * 512 + h * 128 + dg * 8);
#pragma unroll
        for (int e = 0; e < 8; ++e) { const float ex = __expf(-bfe(fw, e)), sg = 1.f / (1.f + ex), lb = lbv[e];
            g[e] = __logf(lb + (1.f - lb) * sg); k[e] = (1.f - lb) * (ex * sg); }
        if (need_q) { const u32x4 qw = *(const u32x4*)(prow + C_HQ + h * 128 + dg * 8);
#pragma unroll
            for (int e = 0; e < 8; ++e) q[e] = silu_f(bfe(qw, e)); }
    }
}
__device__ __forceinline__ void load_lb(const Args& a, int l, int dir, int h, int dg, float* lbv) {
    const float* hlb = a.in[11];
#pragma unroll
    for (int e = 0; e < 8; ++e) { float lb = 0.f;
        if (l == 1) { const float b0 = hlb[dir * 512 + h * 128 + dg * 8 + e], b1 = hlb[(2 + dir) * 512 + h * 128 + dg * 8 + e]; lb = 1.f / (1.f + __expf(b0 - b1)); }
        lbv[e] = lb; }
}
__device__ __forceinline__ void stage_w2(const Args& a, int l, int dir, int h, LAS float* W2L, int tid) {
    const float* w2 = a.in[8] + (size_t)((l * 2 + dir) * 16) * 256 + h * 64;
    const float* ba = a.in[9] + (l * 2 + dir) * 256 + h * 64;
    const float v0 = w2[(tid >> 6) * 256 + (tid & 63)], v1 = w2[((tid + 512) >> 6) * 256 + (tid & 63)], v2 = tid < 64 ? ba[tid] : 0.f;
    W2L[tid] = v0; W2L[tid + 512] = v1; if (tid < 64) W2L[1024 + tid] = v2;
}
template <int DK> __device__ __forceinline__ void cumsum_p(LAS float* CF, LAS float* SG, int tid) {
    constexpr int CS = DK + 4, NSEG = NTHR / DK, SL = 64 / NSEG;
    const int d = tid % DK, sg = tid / DK;
    float run = 0.f;
#pragma unroll 4
    for (int p = sg * SL; p < sg * SL + SL; ++p) { run += CF[p * CS + d]; CF[p * CS + d] = run; }
    SG[sg * DK + d] = run;
    __syncthreads();
    float off = 0.f;
    for (int s2 = 0; s2 < sg; ++s2) off += SG[s2 * DK + d];
#pragma unroll 4
    for (int p = sg * SL; p < sg * SL + SL; ++p) CF[p * CS + d] += off;
    __syncthreads();
}
__device__ __forceinline__ int scan_chunk(int seg, int c, int dir) { return seg ? 4 + (dir ? 63 - c : c) : (dir ? 3 - c : c); }

template <int MX> __device__ __forceinline__ void s1_item(const Args& a, int l, const bf16* P, int bh, int seg, int c, int dir, LAS unsigned char* L, int tid, int lane, int wave) {
    asm volatile("" : "+v"(tid), "+v"(lane), "+s"(wave));
    constexpr int DK = MX ? 128 : 64, DB = DK + 8, CS = DK + 4, NDG = DK / 8, UPT = (64 * NDG) / NTHR, NT = DK / 16;
    LAS float* CF = (LAS float*)L;
    LAS bf16* KB = (LAS bf16*)(L + 33792);
    LAS bf16* VB = (LAS bf16*)(L + 51200);
    LAS float* SG = (LAS float*)(L + 68608);
    LAS float* W2L = (LAS float*)(L + 70656);
    const int b = bh >> 2, h = bh & 3;
    const int row0 = seg ? b * SEQ + c * 64 : NLAT + b * CTX + c * 64;
    const int vcol = (MX ? C_HI : C_GV) + h * 128;
    if (MX == 0) stage_w2(a, l, dir, h, W2L, tid);
#pragma unroll
    for (int t = 0; t < 2; ++t) { const int u = tid + NTHR * t, p = u >> 4, ch = u & 15, j = dir ? 63 - p : p;
        *(LAS u32x4*)(VB + p * 136 + ch * 8) = *(const u32x4*)(P + (size_t)(row0 + j) * LDP + vcol + ch * 8); }
    __syncthreads();
    float kv[UPT][8];
    {
        float lbv[8];
        if (MX == 1) load_lb(a, l, dir, h, tid % NDG, lbv);
#pragma unroll
        for (int t = 0; t < UPT; ++t) { const int u = tid + NTHR * t, p = u / NDG, dg = u % NDG, j = dir ? 63 - p : p;
            float g[8], qd[8];
            load_unit<MX>(a, P + (size_t)(row0 + j) * LDP, h, dg, seg, c, j, dir, false, lbv, W2L, qd, kv[t], g);
            *(LAS f32x4*)(CF + p * CS + dg * 8) = (f32x4){g[0], g[1], g[2], g[3]}; *(LAS f32x4*)(CF + p * CS + dg * 8 + 4) = (f32x4){g[4], g[5], g[6], g[7]}; }
    }
    __syncthreads();
    cumsum_p<DK>(CF, SG, tid);
#pragma unroll
    for (int t = 0; t < UPT; ++t) { const int u = tid + NTHR * t, p = u / NDG, dg = u % NDG;
        float o[8];
#pragma unroll
        for (int e = 0; e < 8; ++e) o[e] = kv[t][e] * __expf(CF[63 * CS + dg * 8 + e] - CF[p * CS + dg * 8 + e]);
        *(LAS u32x4*)(KB + p * DB + dg * 8) = pack8(o); }
    const int sc = scan_chunk(seg, c, dir);
    const size_t sidx = (size_t)((bh * 2 + dir) * NSC + sc);
    float* ST = (float*)(a.ws + (MX ? WS_STH : WS_STG)) + sidx * (DK * 128);
    float* DC = (float*)(a.ws + (MX ? WS_DCH : WS_DCG)) + sidx * DK;
    if (tid < DK) DC[tid] = __expf(CF[63 * CS + tid]);
    __syncthreads();
    const int dt = wave % NT, vb = (wave / NT) * NT, quad = lane >> 4, l15 = lane & 15;
    f32x4 acc[NT];
#pragma unroll
    for (int t = 0; t < NT; ++t) acc[t] = (f32x4){0.f, 0.f, 0.f, 0.f};
#pragma unroll
    for (int ks = 0; ks < 2; ++ks) { const bf16x8 af = frag_tr(KB, DB, ks * 32, dt * 16, lane);
#pragma unroll
        for (int t = 0; t < NT; ++t) acc[t] = MFMA16(af, frag_tr(VB, 136, ks * 32, (vb + t) * 16, lane), acc[t]); }
#pragma unroll
    for (int t = 0; t < NT; ++t)
#pragma unroll
        for (int jj = 0; jj < 4; ++jj) ST[(dt * 16 + quad * 4 + jj) * 128 + (vb + t) * 16 + l15] = acc[t][jj];
    __syncthreads();
}

template <int DK> __device__ __forceinline__ void cumsum_p2(LAS float* CF0, LAS float* CF1, LAS float* SG, int tid) {
    constexpr int CS = DK + 4, NSEG = NTHR / DK, SL = 64 / NSEG;
    const int d = tid % DK, sg = tid / DK;
    float run0 = 0.f, run1 = 0.f;
#pragma unroll 4
    for (int p = sg * SL; p < sg * SL + SL; ++p) { run0 += CF0[p * CS + d]; CF0[p * CS + d] = run0; run1 += CF1[p * CS + d]; CF1[p * CS + d] = run1; }
    SG[sg * DK + d] = run0; SG[512 + sg * DK + d] = run1;
    __syncthreads();
    float off0 = 0.f, off1 = 0.f;
    for (int s2 = 0; s2 < sg; ++s2) { off0 += SG[s2 * DK + d]; off1 += SG[512 + s2 * DK + d]; }
#pragma unroll 4
    for (int p = sg * SL; p < sg * SL + SL; ++p) { CF0[p * CS + d] += off0; CF1[p * CS + d] += off1; }
    __syncthreads();
}
template <int MX> __device__ __forceinline__ void s1_item2(const Args& a, int l, const bf16* P, int bh, int seg, int c, LAS unsigned char* L, int tid, int lane, int wave) {
    asm volatile("" : "+v"(tid), "+v"(lane), "+s"(wave));
    constexpr int DK = MX ? 128 : 64, DB = DK + 8, CS = DK + 4, NDG = DK / 8, UPT = (64 * NDG) / NTHR, NT = DK / 16;
    LAS float* CF0 = (LAS float*)L;
    LAS float* CF1 = (LAS float*)(L + 33792);
    LAS bf16* KB0 = (LAS bf16*)(L + 67584);
    LAS bf16* KB1 = (LAS bf16*)(L + 84992);
    LAS bf16* VB = (LAS bf16*)(L + 102400);
    LAS float* SG = (LAS float*)(L + 119808);
    LAS float* W2L = (LAS float*)(L + 123904);
    const int b = bh >> 2, h = bh & 3;
    const int row0 = seg ? b * SEQ + c * 64 : NLAT + b * CTX + c * 64;
    const int vcol = (MX ? C_HI : C_GV) + h * 128;
    if (MX == 0) { stage_w2(a, l, 0, h, W2L, tid); stage_w2(a, l, 1, h, W2L + 1088, tid); }
#pragma unroll
    for (int t = 0; t < 2; ++t) { const int u = tid + NTHR * t, j = u >> 4, ch = u & 15;
        *(LAS u32x4*)(VB + j * 136 + ch * 8) = *(const u32x4*)(P + (size_t)(row0 + j) * LDP + vcol + ch * 8); }
    __syncthreads();
    float kv0[UPT][8], kv1[UPT][8];
    {
        float lbv0[8], lbv1[8];
        if (MX == 1) { load_lb(a, l, 0, h, tid % NDG, lbv0); load_lb(a, l, 1, h, tid % NDG, lbv1); }
#pragma unroll
        for (int t = 0; t < UPT; ++t) { const int u = tid + NTHR * t, j = u / NDG, dg = u % NDG;
            float g0[8], g1[8], qd[8];
            load_unit<MX>(a, P + (size_t)(row0 + j) * LDP, h, dg, seg, c, j, 0, false, lbv0, W2L, qd, kv0[t], g0);
            *(LAS f32x4*)(CF0 + j * CS + dg * 8) = (f32x4){g0[0], g0[1], g0[2], g0[3]}; *(LAS f32x4*)(CF0 + j * CS + dg * 8 + 4) = (f32x4){g0[4], g0[5], g0[6], g0[7]};
            __builtin_amdgcn_sched_barrier(0);
            load_unit<MX>(a, P + (size_t)(row0 + j) * LDP, h, dg, seg, c, j, 1, false, lbv1, W2L + 1088, qd, kv1[t], g1);
            *(LAS f32x4*)(CF1 + (63 - j) * CS + dg * 8) = (f32x4){g1[0], g1[1], g1[2], g1[3]}; *(LAS f32x4*)(CF1 + (63 - j) * CS + dg * 8 + 4) = (f32x4){g1[4], g1[5], g1[6], g1[7]};
            __builtin_amdgcn_sched_barrier(0); }
    }
    __syncthreads();
    cumsum_p2<DK>(CF0, CF1, SG, tid);
#pragma unroll
    for (int t = 0; t < UPT; ++t) { const int u = tid + NTHR * t, j = u / NDG, dg = u % NDG;
        float o[8];
#pragma unroll
        for (int e = 0; e < 8; ++e) o[e] = kv0[t][e] * __expf(CF0[63 * CS + dg * 8 + e] - CF0[j * CS + dg * 8 + e]);
        *(LAS u32x4*)(KB0 + j * DB + dg * 8) = pack8(o);
#pragma unroll
        for (int e = 0; e < 8; ++e) o[e] = kv1[t][e] * __expf(CF1[63 * CS + dg * 8 + e] - CF1[(63 - j) * CS + dg * 8 + e]);
        *(LAS u32x4*)(KB1 + j * DB + dg * 8) = pack8(o); }
    const size_t sidx0 = (size_t)((bh * 2 + 0) * NSC + scan_chunk(seg, c, 0)), sidx1 = (size_t)((bh * 2 + 1) * NSC + scan_chunk(seg, c, 1));
    bf16* STb = (bf16*)(a.ws + (MX ? WS_STH : WS_STG)); float* DCb = (float*)(a.ws + (MX ? WS_DCH : WS_DCG));
    if (tid < DK) { DCb[sidx0 * DK + tid] = __expf(CF0[63 * CS + tid]); DCb[sidx1 * DK + tid] = __expf(CF1[63 * CS + tid]); }
    __syncthreads();
    const int dt = wave % NT, vb = (wave / NT) * NT;
#pragma unroll 1
    for (int dir = 0; dir < 2; ++dir) {
        int lane2 = lane; asm volatile("" : "+v"(lane2));
        const int quad = lane2 >> 4, l15 = lane2 & 15;
        const LAS bf16* KB = dir ? KB1 : KB0; bf16* ST = STb + (dir ? sidx1 : sidx0) * (DK * 128);
        f32x4 acc[NT];
#pragma unroll
        for (int t = 0; t < NT; ++t) acc[t] = (f32x4){0.f, 0.f, 0.f, 0.f};
#pragma unroll
        for (int ks = 0; ks < 2; ++ks) { const bf16x8 kfr = frag_tr(KB, DB, ks * 32, dt * 16, lane2);
#pragma unroll
            for (int t = 0; t < NT; ++t) acc[t] = MFMA16(frag_tr(VB, 136, ks * 32, (vb + t) * 16, lane2), kfr, acc[t]); }
#pragma unroll
        for (int t = 0; t < NT; ++t) { u32x2 w; w.x = pk2(acc[t][0], acc[t][1]); w.y = pk2(acc[t][2], acc[t][3]);
            *(u32x2*)(ST + (dt * 16 + l15) * 128 + (vb + t) * 16 + quad * 4) = w; }
    }
    __syncthreads();
}

__device__ __forceinline__ void s2_phase(const Args& a, int gtid, int nthreads) {
    for (int e4 = gtid; e4 < 98304; e4 += nthreads) {
        const bf16* st; bf16* sb; const float* dc; int ss, sd;
        if (e4 < 32768) { const int sq = e4 >> 11, rem = (e4 & 2047) * 4; st = (const bf16*)(a.ws + WS_STG) + (size_t)sq * NSC * 8192 + rem; sb = (bf16*)(a.ws + WS_SBG) + (size_t)sq * NSC * 8192 + rem;
            dc = (const float*)(a.ws + WS_DCG) + sq * NSC * 64 + (rem >> 7); ss = 8192; sd = 64; }
        else { const int e2 = e4 - 32768, sq = e2 >> 12, rem = (e2 & 4095) * 4; st = (const bf16*)(a.ws + WS_STH) + (size_t)sq * NSC * 16384 + rem; sb = (bf16*)(a.ws + WS_SBH) + (size_t)sq * NSC * 16384 + rem;
            dc = (const float*)(a.ws + WS_DCH) + sq * NSC * 128 + (rem >> 7); ss = 16384; sd = 128; }
        f32x4 S = (f32x4){0.f, 0.f, 0.f, 0.f};
#pragma unroll 17
        for (int sc = 0; sc < NSC; ++sc) { const u32x2 lw = *(const u32x2*)(st + (size_t)sc * ss); const float dv = dc[sc * sd];
            const f32x4 Lv = (f32x4){bf2f(lw.x & 0xffffu), bf2f(lw.x >> 16), bf2f(lw.y & 0xffffu), bf2f(lw.y >> 16)};
            u32x2 w; w.x = pk2(S.x, S.y); w.y = pk2(S.z, S.w); *(u32x2*)(sb + (size_t)sc * ss) = w; S = S * dv + Lv; }
    }
}

template <int MX> __device__ __forceinline__ void s3_item(const Args& a, int l, const bf16* P, bf16* Y, int bh, int seg, int c, LAS unsigned char* L, int tid, int lane, int wave) {
    asm volatile("" : "+v"(tid), "+v"(lane), "+s"(wave));
    constexpr int DK = MX ? 128 : 64, DB = DK + 8, CS = DK + 4, NDG = DK / 8, UPT = (64 * NDG) / NTHR, NS0 = (DK * 16) / NTHR;
    LAS float* CF = (LAS float*)L;
    LAS bf16* QT = (LAS bf16*)(L + 33792);
    LAS bf16* KD = (LAS bf16*)(L + 51200);
    LAS bf16* KO = (LAS bf16*)(L + 68608);
    LAS bf16* S0B = (LAS bf16*)(L + 51200);
    LAS bf16* QS = (LAS bf16*)(L + 94720);
    LAS bf16* VB = (LAS bf16*)(L + 112128);
    LAS bf16* ATT = (LAS bf16*)(L + 129536);
    LAS float* SG = (LAS float*)(L + 138752);
    LAS float* W2L = (LAS float*)(L + 140800);
    LAS float* OF = (LAS float*)L;
    const int b = bh >> 2, h = bh & 3;
    const int row0 = seg ? b * SEQ + c * 64 : NLAT + b * CTX + c * 64;
    const int vcol = (MX ? C_HI : C_GV) + h * 128;
    const int it_ = wave & 3, vb = (wave >> 2) * 4, quad = lane >> 4, l15 = lane & 15;
    f32x4 acc[4];
#pragma unroll
    for (int t = 0; t < 4; ++t) acc[t] = (f32x4){0.f, 0.f, 0.f, 0.f};
#pragma unroll
    for (int t = 0; t < 2; ++t) { const int u = tid + NTHR * t, j = u >> 4, ch = u & 15;
        *(LAS u32x4*)(VB + j * 136 + ch * 8) = *(const u32x4*)(P + (size_t)(row0 + j) * LDP + vcol + ch * 8); }
#pragma unroll 1
    for (int dir = 0; dir < 2; ++dir) {
        if (MX == 0) { stage_w2(a, l, dir, h, W2L, tid); __syncthreads(); }
        float qv[UPT][8], kv[UPT][8];
        {
            float lbv[8];
            if (MX == 1) load_lb(a, l, dir, h, tid % NDG, lbv);
#pragma unroll
            for (int t = 0; t < UPT; ++t) { const int u = tid + NTHR * t, p = u / NDG, dg = u % NDG, j = dir ? 63 - p : p;
                float g[8];
                load_unit<MX>(a, P + (size_t)(row0 + j) * LDP, h, dg, seg, c, j, dir, true, lbv, W2L, qv[t], kv[t], g);
                *(LAS f32x4*)(CF + p * CS + dg * 8) = (f32x4){g[0], g[1], g[2], g[3]}; *(LAS f32x4*)(CF + p * CS + dg * 8 + 4) = (f32x4){g[4], g[5], g[6], g[7]}; }
        }
        __syncthreads();
        cumsum_p<DK>(CF, SG, tid);
#pragma unroll
        for (int t = 0; t < UPT; ++t) { const int u = tid + NTHR * t, p = u / NDG, dg = u % NDG, j = dir ? 63 - p : p, sa = p >> 4;
            float cc[8], rf[8], o[8];
            { const f32x4 c0 = *(const LAS f32x4*)(CF + p * CS + dg * 8), c1 = *(const LAS f32x4*)(CF + p * CS + dg * 8 + 4);
#pragma unroll
              for (int e = 0; e < 4; ++e) { cc[e] = c0[e]; cc[4 + e] = c1[e]; } }
            if (sa > 0) { const f32x4 r0 = *(const LAS f32x4*)(CF + (16 * sa - 1) * CS + dg * 8), r1 = *(const LAS f32x4*)(CF + (16 * sa - 1) * CS + dg * 8 + 4);
#pragma unroll
              for (int e = 0; e < 4; ++e) { rf[e] = r0[e]; rf[4 + e] = r1[e]; } }
            else {
#pragma unroll
              for (int e = 0; e < 8; ++e) rf[e] = 0.f; }
#pragma unroll
            for (int e = 0; e < 8; ++e) o[e] = qv[t][e] * __expf(cc[e] - rf[e]);
            *(LAS u32x4*)(QT + p * DB + dg * 8) = pack8(o);
#pragma unroll
            for (int e = 0; e < 8; ++e) o[e] = kv[t][e] * __expf(fminf(rf[e] - cc[e], 80.f));
            *(LAS u32x4*)(KD + p * DB + dg * 8) = pack8(o);
#pragma unroll
            for (int e = 0; e < 8; ++e) o[e] = qv[t][e] * __expf(cc[e]);
            *(LAS u32x4*)(QS + j * DB + dg * 8) = pack8(o);
            for (int a2 = sa + 1; a2 < 4; ++a2) { const f32x4 r0 = *(const LAS f32x4*)(CF + (16 * a2 - 1) * CS + dg * 8), r1 = *(const LAS f32x4*)(CF + (16 * a2 - 1) * CS + dg * 8 + 4);
#pragma unroll
                for (int e = 0; e < 4; ++e) { o[e] = kv[t][e] * __expf(r0[e] - cc[e]); o[4 + e] = kv[t][4 + e] * __expf(r1[e] - cc[4 + e]); }
                *(LAS u32x4*)(KO + ((a2 == 1 ? 0 : (a2 == 2 ? 16 : 48)) + p) * DB + dg * 8) = pack8(o); }
        }
        u32x4 s0r[NS0];
        {
            const int sc = scan_chunk(seg, c, dir);
            const bf16* SB = (const bf16*)(a.ws + (MX ? WS_SBH : WS_SBG)) + (size_t)((bh * 2 + dir) * NSC + sc) * (DK * 128);
#pragma unroll
            for (int t = 0; t < NS0; ++t) s0r[t] = *(const u32x4*)(SB + (size_t)(tid + NTHR * t) * 8);
        }
        __syncthreads();
#pragma unroll
        for (int t2 = 0; t2 < 2; ++t2) { const int s = wave * 2 + t2, sa = s >> 2, sb = s & 3;
            f32x4 sacc = (f32x4){0.f, 0.f, 0.f, 0.f};
            if (sb <= sa) {
                const LAS bf16* kb = (sa == sb) ? KD + (16 * sa) * DB : KO + ((sa == 1 ? 0 : (sa == 2 ? 16 : 48)) + 16 * sb) * DB;
#pragma unroll
                for (int ks = 0; ks < DK / 32; ++ks) sacc = MFMA16(frag(kb, DB, 0, ks * 32, lane), frag(QT, DB, 16 * sa, ks * 32, lane), sacc);
            }
            float v[4];
#pragma unroll
            for (int jj = 0; jj < 4; ++jj) v[jj] = (sb < sa || (sb == sa && quad * 4 + jj <= l15)) ? sacc[jj] : 0.f;
            const int p = 16 * sa + l15, pp0 = 16 * sb + quad * 4;
            u32x2 w;
            if (dir) { w.x = cvtpk(v[3], v[2]); w.y = cvtpk(v[1], v[0]); *(LAS u32x2*)(ATT + (63 - p) * 72 + 60 - pp0) = w; }
            else { w.x = cvtpk(v[0], v[1]); w.y = cvtpk(v[2], v[3]); *(LAS u32x2*)(ATT + p * 72 + pp0) = w; } }
        __syncthreads();
#pragma unroll
        for (int t = 0; t < NS0; ++t) { const int u = tid + NTHR * t, d = u >> 4, ch = u & 15; *(LAS u32x4*)(S0B + d * 136 + ch * 8) = s0r[t]; }
        __syncthreads();
#pragma unroll
        for (int ks = 0; ks < 2; ++ks) { const bf16x8 af = frag(ATT, 72, it_ * 16, ks * 32, lane);
#pragma unroll
            for (int t = 0; t < 4; ++t) acc[t] = MFMA16(af, frag_tr(VB, 136, ks * 32, (vb + t) * 16, lane), acc[t]); }
#pragma unroll
        for (int ks = 0; ks < DK / 32; ++ks) { const bf16x8 af = frag(QS, DB, it_ * 16, ks * 32, lane);
#pragma unroll
            for (int t = 0; t < 4; ++t) acc[t] = MFMA16(af, frag_tr(S0B, 136, ks * 32, (vb + t) * 16, lane), acc[t]); }
        __syncthreads();
    }
    const int gcol = (MX ? C_HG : C_GR) + h * 128, ycol = (MX ? 512 : 0) + h * 128;
    unsigned gwv[8];
#pragma unroll
    for (int rr = 0; rr < 8; ++rr) gwv[rr] = *(const unsigned*)(P + (size_t)(row0 + wave * 8 + rr) * LDP + gcol + lane * 2);
#pragma unroll
    for (int t = 0; t < 4; ++t)
#pragma unroll
        for (int jj = 0; jj < 4; ++jj) OF[(it_ * 16 + quad * 4 + jj) * 132 + (vb + t) * 16 + l15] = acc[t][jj];
    __syncthreads();
    const float* ng = (MX ? a.in[12] : a.in[10]) + l * 128;
    const float n0 = ng[lane * 2], n1 = ng[lane * 2 + 1];
#pragma unroll
    for (int rr = 0; rr < 8; ++rr) { const int i = wave * 8 + rr;
        const float o0 = OF[i * 132 + lane * 2], o1 = OF[i * 132 + lane * 2 + 1];
        const float rstd = rsqrtf(wave_sum(o0 * o0 + o1 * o1) * (1.f / 128.f) + 1e-6f);
        const unsigned gw = gwv[rr];
        const float y0 = o0 * rstd * n0 * silu_f(bf2f(gw & 0xffffu)), y1 = o1 * rstd * n1 * silu_f(bf2f(gw >> 16));
        *(unsigned*)(Y + (size_t)(row0 + i) * DM + ycol + lane * 2) = pk2(y0, y1); }
    __syncthreads();
}


template <int MODE> __device__ __forceinline__ void sgemm_ctx(const bf16* A, const bf16* Bt, int K, int N, int S, bf16* O, float* PART,
                                                              LAS unsigned char* L, int tid, int lane, int wave, int bid, int G) {
    const int ntn = N / 128, nitems = 4 * ntn * S, kspan = K / S, ns = kspan / 128;
    const int uj = tid >> 4, uc = (tid & 15) * 8;
    const int wm = wave & 3, wn = wave >> 2, quad = lane >> 4, l15 = lane & 15;
#pragma unroll 1
    for (int it = bid; it < nitems; it += G) {
        const int sp = it % S, r1 = it / S, tn = r1 % ntn, tm = r1 / ntn;
        const bf16* Ap = A + (size_t)(tm * 128 + uj) * K + sp * kspan + uc; const bf16* Bp = Bt + (size_t)(tn * 128 + uj) * K + sp * kspan + uc;
        u32x4 ra[4], rb[4], rc[4], rd[4];
#define SG_LOAD(ra_, rb_, st_) do { _Pragma("unroll") for (int t = 0; t < 4; ++t) { ra_[t] = *(const u32x4*)(Ap + (size_t)(32 * t) * K + (st_) * 128); rb_[t] = *(const u32x4*)(Bp + (size_t)(32 * t) * K + (st_) * 128); } } while (0)
#define SG_STORE(ra_, rb_, buf_) do { LAS bf16* An_ = (LAS bf16*)L + (buf_) * 34816; _Pragma("unroll") for (int t = 0; t < 4; ++t) { *(LAS u32x4*)(An_ + (uj + 32 * t) * 136 + uc) = ra_[t]; *(LAS u32x4*)(An_ + 17408 + (uj + 32 * t) * 136 + uc) = rb_[t]; } } while (0)
#define SG_COMPUTE(buf_) do { const LAS bf16* As = (const LAS bf16*)L + (buf_) * 34816; const LAS bf16* Bs = As + 17408; \
            _Pragma("unroll") for (int ks = 0; ks < 4; ++ks) { const bf16x8 af0 = frag(As, 136, wm * 32, ks * 32, lane), af1 = frag(As, 136, wm * 32 + 16, ks * 32, lane); \
                _Pragma("unroll") for (int t = 0; t < 4; ++t) { const bf16x8 bfm = frag(Bs, 136, wn * 64 + t * 16, ks * 32, lane); \
                    acc[0][t] = MFMA16(af0, bfm, acc[0][t]); acc[1][t] = MFMA16(af1, bfm, acc[1][t]); } } } while (0)
        SG_LOAD(ra, rb, 0);
        if (ns > 1) SG_LOAD(rc, rd, 1);
        SG_STORE(ra, rb, 0);
        if (ns > 2) SG_LOAD(ra, rb, 2);
        __syncthreads();
        f32x4 acc[2][4];
#pragma unroll
        for (int i = 0; i < 2; ++i)
#pragma unroll
            for (int t = 0; t < 4; ++t) acc[i][t] = (f32x4){0.f, 0.f, 0.f, 0.f};
#pragma unroll 1
        for (int s = 0; s < ns; s += 2) {
            SG_COMPUTE(0);
            if (s + 1 < ns) SG_STORE(rc, rd, 1);
            if (s + 3 < ns) SG_LOAD(rc, rd, s + 3);
            __syncthreads();
            if (s + 1 < ns) {
                SG_COMPUTE(1);
                if (s + 2 < ns) SG_STORE(ra, rb, 0);
                if (s + 4 < ns) SG_LOAD(ra, rb, s + 4);
                __syncthreads();
            }
        }
#undef SG_LOAD
#undef SG_STORE
#undef SG_COMPUTE
#pragma unroll
        for (int i = 0; i < 2; ++i)
#pragma unroll
            for (int t = 0; t < 4; ++t) { const int col = tn * 128 + wn * 64 + t * 16 + l15;
#pragma unroll
                for (int jj = 0; jj < 4; ++jj) { const int row = tm * 128 + wm * 32 + i * 16 + quad * 4 + jj;
                    if (MODE == 1) { const float v = acc[i][t][jj] > 0.f ? acc[i][t][jj] : 0.f; O[(size_t)row * N + col] = (bf16)f2bf(v * v); }
                    else PART[((size_t)sp * 512 + row) * N + col] = acc[i][t][jj]; } }
    }
}

#define XB_TMO      128
#define XB_XCNT(j)  (256  + 64 * (j))
#define XB_XSUB(j)  (1280 + 64 * (j))
#define XB_XGEN(j)  (2304 + 64 * (j))
#define XB_TOP      3328
#define XB_TOPGEN   3392
#define XCD_BAR_WORDS 3456
#define XB_SPIN_CAP (1u << 18)

__device__ __forceinline__ unsigned xb_ld(unsigned* p)              { return __hip_atomic_load(p, __ATOMIC_RELAXED, __HIP_MEMORY_SCOPE_AGENT); }
__device__ __forceinline__ unsigned xb_add(unsigned* p, unsigned v) { return __hip_atomic_fetch_add(p, v, __ATOMIC_RELAXED, __HIP_MEMORY_SCOPE_AGENT); }
__device__ __forceinline__ unsigned xb_xcc_id() { return (unsigned)__builtin_amdgcn_s_getreg((3 << 11) | 20) & 0xFu; }
#define XB_SPIN(cond, bar) do { unsigned _sp = 0; while (cond) { __builtin_amdgcn_s_sleep(1); \
    if ((++_sp & 255u) == 0u) { if (xb_ld(&(bar)[XB_TMO])) break; if (_sp > XB_SPIN_CAP) { atomicAdd(&(bar)[XB_TMO], 1u); break; } } } } while (0)

struct XcdBarrier {
    unsigned* bar; unsigned x;
    volatile LAS unsigned* st;
};

__device__ __forceinline__ XcdBarrier xcd_barrier_post(unsigned* bar, volatile LAS unsigned* st) {
    XcdBarrier b; b.bar = bar; b.x = xb_xcc_id(); b.st = st;
    if (threadIdx.x == 0) (void)xb_add(&bar[XB_XCNT(b.x)], 1u);
    return b;
}
__device__ __forceinline__ void xcd_barrier_complete(unsigned* bar, unsigned x, unsigned& nloc, unsigned& nx) {
    const unsigned G = gridDim.x * gridDim.y * gridDim.z;
    unsigned sum, cnt, mine, sp = 0u;
    for (;;) {
        sum = 0u; cnt = 0u; mine = 0u;
#pragma unroll
        for (unsigned j = 0; j < 16; ++j) { const unsigned c = xb_ld(&bar[XB_XCNT(j)]); sum += c; cnt += (c > 0u) ? 1u : 0u; mine = (j == x) ? c : mine; }
        if (sum == G) break;
        __builtin_amdgcn_s_sleep(1);
        if ((++sp & 255u) == 0u) { if (xb_ld(&bar[XB_TMO])) break; if (sp > XB_SPIN_CAP) { atomicAdd(&bar[XB_TMO], 1u); break; } }
    }
    nloc = mine > 0u ? mine : 1u; nx = cnt > 0u ? cnt : 1u;
}

__device__ __forceinline__ void xcd_barrier(const XcdBarrier& b) {
    asm volatile("s_waitcnt vmcnt(0)" ::: "memory");
    __syncthreads();
    if (threadIdx.x == 0) {
        unsigned* bar = b.bar;
        __builtin_amdgcn_s_waitcnt(0);
        unsigned nloc = b.st[0], nx = b.st[1];
        if (nloc == 0u) { xcd_barrier_complete(bar, b.x, nloc, nx); b.st[0] = nloc; b.st[1] = nx; }
        const unsigned old = xb_add(&bar[XB_XSUB(b.x)], 1u);
        const unsigned gen = old / nloc;
        if (old + 1u == (gen + 1u) * nloc) {
            __builtin_amdgcn_fence(__ATOMIC_RELEASE, "agent");
            asm volatile("s_waitcnt vmcnt(0)" ::: "memory");
            const unsigned og = xb_add(&bar[XB_TOP], 1u);
            const unsigned tg = og / nx;
            if (og + 1u == (tg + 1u) * nx) xb_add(&bar[XB_TOPGEN], 1u);
            else XB_SPIN(xb_ld(&bar[XB_TOPGEN]) == tg, bar);
            __builtin_amdgcn_fence(__ATOMIC_ACQUIRE, "agent");
            xb_add(&bar[XB_XGEN(b.x)], 1u);
            asm volatile("s_waitcnt vmcnt(0)" ::: "memory");
        } else {
            XB_SPIN(xb_ld(&bar[XB_XGEN(b.x)]) == gen, bar);
            __builtin_amdgcn_fence(__ATOMIC_ACQUIRE, "agent");
            asm volatile("s_waitcnt vmcnt(0)" ::: "memory");
        }
    }
    __syncthreads();
}


constexpr int NSTEPS = 19;
#ifndef PROBE_P0
#define PROBE_P0 0
#endif
#ifndef PROBE_OUT
#define PROBE_OUT 0
#endif
#ifndef PROBE_NA
#define PROBE_NA 0
#endif
#ifndef PROBE_SYNC
#define PROBE_SYNC 0
#endif
#ifndef PROBE_MLP1
#define PROBE_MLP1 0
#endif
#ifndef PROBE_MLP2
#define PROBE_MLP2 0
#endif
#ifndef PROBE_G1
#define PROBE_G1 0
#endif
#ifndef PROBE_K2
#define PROBE_K2 0
#endif
#ifndef PROBE_S3
#define PROBE_S3 0
#endif
#define IN(s) (lo <= (s) && (s) < hi)
#define SEAM(s) do { if (IN(s) && IN((s) + 1)) { if ((s) == 0) cg::this_grid().sync(); else xcd_barrier(xbar); for (int rs_ = 0; rs_ < PROBE_SYNC; ++rs_) xcd_barrier(xbar); } } while (0)
template <int LYR> __device__ __forceinline__ void layer_program(const Args& a, LAS unsigned char* L, const int lo, const int hi, const XcdBarrier& xbar) {
    constexpr int l = LYR;
    const int tid = threadIdx.x, lane = tid & 63, wave = __builtin_amdgcn_readfirstlane(tid >> 6);
    const int bid = blockIdx.x, G = gridDim.x;
    unsigned char* ws = a.ws;
        const int s0 = 1 + 9 * l;
        const bool last = (l == 1);
        const int mrows = last ? NLAT : MTOK;
        const float* modl = (const float*)(ws + WS_MOD) + (size_t)l * 3 * 12288;
        bf16* H = (bf16*)(ws + WS_H); bf16* Y = (bf16*)(ws + WS_Y); bf16* X = (bf16*)(ws + WS_X); bf16* P = (bf16*)(ws + WS_P); bf16* HID = (bf16*)(ws + WS_HID);
        if (IN(s0 + 0)) {
            if (l == 0) norm_phase<0, 0>(a.in[0], a.in[2], MTOK, a.in[6] + l * DM, modl, 0, 2048, H, lane, bid * 8 + wave, G * 8);
            else norm_phase<1, 1>(X, X + (size_t)NLAT * DM, MTOK, a.in[6] + l * DM, modl, 0, 2048, H, lane, bid * 8 + wave, G * 8,
                            (const float*)(ws + WS_PART), (const float*)(ws + WS_MOD) + 2 * 12288 + 10240, X + (size_t)NLAT * DM);
        }
        SEAM(s0 + 0);
        if (IN(s0 + 1)) {
#ifndef NO_GEMM
            pg8::Gemm g{H, (const bf16*)(ws + WS_WIN + l * SZ_WIN), MTOK, LDP, DM}; pg8::StaticOrder S; S.init(MTOK, LDP, G, bid);
            pg8::EpiStoreBf16<0> E{P, LDP};
            for (int rep = 0; rep < 1 + PROBE_G1; ++rep) pg8::gemm_phase<pg8::EpiStoreBf16<0>, pg8::StaticOrder, false, true>(L, g, S, E);
#endif
        }
        SEAM(s0 + 1);
        if (IN(s0 + 2)) {
            for (int rep = 0; rep < 1 + PROBE_K2; ++rep)
            for (int it = bid; it < 1088; it += G) {
                const int mx = ((it >> 8) + it + 1) & 1, r2 = it >> 1, bh = r2 / NSC, cc = r2 % NSC;
                const int seg = cc >= 4, c = seg ? cc - 4 : cc;
#ifndef NO_S1
                if (mx == 0) s1_item2<0>(a, l, P, bh, seg, c, L, tid, lane, wave); else s1_item2<1>(a, l, P, bh, seg, c, L, tid, lane, wave);
#endif
            }
        }
        SEAM(s0 + 2);
        if (IN(s0 + 3)) s2_phase(a, bid * NTHR + tid, G * NTHR);
        SEAM(s0 + 3);
        if (IN(s0 + 4)) {
            const int n_na = last ? 256 : 272;
            for (int rep = 0; rep < 1 + PROBE_S3 + PROBE_NA; ++rep)
            for (int it = bid; it < n_na + 1088; it += G) {
                if (rep > 0 && PROBE_NA && it >= n_na) continue;
                if (rep > 0 && PROBE_S3 && it < n_na) continue;
                if (it < n_na) {
#ifndef NO_NA
                    if (it < 256) { const int itx = (G == 256) ? ((it & 7) * 32 + (it >> 3)) : it;
                        const int b = itx >> 7, h = (itx >> 4) & 7, band = itx & 15; na_band(a, l, P, Y, b, h, band * 4, 1, L, tid, lane, wave); }
                    else { const int i2 = it - 256, b = i2 >> 3, h = i2 & 7; na_band(a, l, P, Y, b, h, 0, 0, L, tid, lane, wave); }
#endif
                } else {
                    const int i2 = it - n_na, mx = ((i2 >> 8) + i2 + 1) & 1, r2 = i2 >> 1, bh = r2 / NSC, cc = r2 % NSC;
                    const int seg = cc >= 4, c = seg ? cc - 4 : cc;
                    if (last && !seg) continue;
#ifndef NO_S3
                    if (mx == 0) s3_item<0>(a, l, P, Y, bh, seg, c, L, tid, lane, wave); else s3_item<1>(a, l, P, Y, bh, seg, c, L, tid, lane, wave);
#endif
                }
            }
        }
        SEAM(s0 + 4);
        if (IN(s0 + 5)) {
#ifndef NO_GEMM
            pg8::Gemm g{Y, (const bf16*)(ws + WS_WOUT + l * SZ_WOUT), NLAT, DM, DM}; pg8::StaticOrder S; S.init(NLAT, DM, G, bid);
            if (l == 0) { pg8::EpiResGateT<0, 1> E{a.in[0], X, modl + 4096}; pg8::gemm_phase<pg8::EpiResGateT<0, 1>, pg8::StaticOrder, false, true>(L, g, S, E); }
            else { pg8::EpiResGateT<1, 1> E{X, X, modl + 4096}; pg8::gemm_phase<pg8::EpiResGateT<1, 1>, pg8::StaticOrder, false, true>(L, g, S, E); }
            if (!last) sgemm_ctx<3>(Y + (size_t)NLAT * DM, (const bf16*)(ws + WS_WOUT + l * SZ_WOUT), DM, DM, 4, nullptr, (float*)(ws + WS_PART), L, tid, lane, wave, bid, G);
#endif
        }
        SEAM(s0 + 5);
        if (IN(s0 + 6)) {
            if (l == 0) norm_phase<1, 0>(X, a.in[2], MTOK, a.in[17] + l * DM, modl, 6144, 8192, H, lane, bid * 8 + wave, G * 8,
                                   (const float*)(ws + WS_PART), modl + 2 * 12288 + 4096, X + (size_t)NLAT * DM);
            else norm_phase<1, 1>(X, X + (size_t)NLAT * DM, NLAT, a.in[17] + l * DM, modl, 6144, 8192, H, lane, bid * 8 + wave, G * 8);
        }
        SEAM(s0 + 6);
        if (IN(s0 + 7)) {
#ifndef NO_GEMM
            pg8::Gemm g{H, (const bf16*)(ws + WS_W1 + l * SZ_W1), NLAT, DFF, DM}; pg8::StaticOrder S; S.init(NLAT, DFF, G, bid);
            pg8::EpiStoreBf16<2> E{HID, DFF};
            for (int rep = 0; rep < 1 + PROBE_MLP1; ++rep) pg8::gemm_phase<pg8::EpiStoreBf16<2>, pg8::StaticOrder, false, true>(L, g, S, E);
            if (!last) sgemm_ctx<1>(H + (size_t)NLAT * DM, (const bf16*)(ws + WS_W1 + l * SZ_W1), DM, DFF, 1, HID + (size_t)NLAT * DFF, nullptr, L, tid, lane, wave, bid, G);
#endif
        }
        SEAM(s0 + 7);
        if (IN(s0 + 8)) {
#ifndef NO_GEMM
            pg8::Gemm g{HID, (const bf16*)(ws + WS_W2 + l * SZ_W2), NLAT, DM, DFF}; pg8::StaticOrder S; S.init(NLAT, DM, G, bid);
            if (!last) { pg8::EpiResGateT<1, 1> E{X, X, modl + 10240}; pg8::gemm_phase<pg8::EpiResGateT<1, 1>, pg8::StaticOrder, false, true>(L, g, S, E); }
            else { pg8::EpiResGateT<1, 0> E{X, a.out, modl + 10240}; pg8::gemm_phase<pg8::EpiResGateT<1, 0>, pg8::StaticOrder, false, true>(L, g, S, E); }
            if (!last) sgemm_ctx<3>(HID + (size_t)NLAT * DFF, (const bf16*)(ws + WS_W2 + l * SZ_W2), DFF, DM, 4, nullptr, (float*)(ws + WS_PART), L, tid, lane, wave, bid, G);
#endif
        }
        SEAM(s0 + 8);
    }
__global__ void __launch_bounds__(NTHR, 2) mk_fwd(Args a) {
    __builtin_assume(__builtin_amdgcn_workitem_id_y() == 0); __builtin_assume(__builtin_amdgcn_workitem_id_z() == 0);
    extern __shared__ __attribute__((aligned(16))) unsigned char lds_raw[];
    LAS unsigned char* L = (LAS unsigned char*)lds_raw;
    const int lo = a.ph_lo, hi = a.ph_hi;
    if (threadIdx.x < 16) ((LAS unsigned*)(L + LDS_MISC))[threadIdx.x] = 0u;
    __syncthreads();
    if (blockIdx.x == 0) for (int i = threadIdx.x; i < 4096; i += NTHR) ((unsigned*)a.ws)[i] = 0u;
    cg::this_grid().sync();
    const XcdBarrier xbar = xcd_barrier_post((unsigned*)a.ws, (volatile LAS unsigned*)(L + LDS_MISC));
    if (IN(0)) {
#ifndef NO_P0
        const int tid = threadIdx.x;
        for (int rep = 0; rep < 1 + PROBE_P0; ++rep) { p0_phase(a, L, tid, tid & 63, __builtin_amdgcn_readfirstlane(tid >> 6), blockIdx.x, gridDim.x); __syncthreads(); }
#endif
    }
    if (IN(0) && IN(1)) xcd_barrier(xbar);
    layer_program<0>(a, L, lo, hi, xbar);
    layer_program<1>(a, L, lo, hi, xbar);
}
#undef IN
#undef SEAM

extern "C" void kernel_launch(void* const* d_in, const int* in_sizes, int n_in, void* d_out, int out_size, void* d_ws, size_t ws_size, hipStream_t stream) {
    static int grid = 0;
    if (grid == 0) {
        if (n_in != 20 || ws_size < WS_END) { fprintf(stderr, "kernel_launch: expected 20 inputs and >= %zu bytes of workspace (got %d, %zu)\n", (size_t)WS_END, n_in, ws_size); grid = -1; return; }
        int dev = 0, cus = 0, per_cu = 0;
        (void)hipGetDevice(&dev); (void)hipDeviceGetAttribute(&cus, hipDeviceAttributeMultiprocessorCount, dev);
        if (hipFuncSetAttribute((const void*)mk_fwd, hipFuncAttributeMaxDynamicSharedMemorySize, LDS_BYTES) != hipSuccess) { fprintf(stderr, "kernel_launch: hipFuncSetAttribute failed\n"); grid = -1; return; }
        if (hipOccupancyMaxActiveBlocksPerMultiprocessor(&per_cu, (const void*)mk_fwd, NTHR, LDS_BYTES) != hipSuccess || per_cu < 1) { fprintf(stderr, "kernel_launch: occupancy query gave %d\n", per_cu); per_cu = 1; }
        (void)hipGetLastError();
        grid = cus * per_cu;
        if (grid > 256) grid = 256;
    }
    if (grid < 0) return;
    Args a{};
    for (int i = 0; i < 20; ++i) a.in[i] = (const float*)d_in[i];
    a.out = (float*)d_out; a.ws = (unsigned char*)d_ws;
#if MK_ONE_LAUNCH
    a.ph_lo = 0; a.ph_hi = NSTEPS;
    void* args[] = {&a};
    hipError_t e = hipLaunchCooperativeKernel((const void*)mk_fwd, dim3(grid), dim3(NTHR), args, LDS_BYTES, stream);
    if (e != hipSuccess) fprintf(stderr, "kernel_launch: cooperative launch failed: %s (grid %d)\n", hipGetErrorString(e), grid);
#else
    for (int s = 0; s < NSTEPS; ++s) { a.ph_lo = s; a.ph_hi = s + 1; hipLaunchKernelGGL(mk_fwd, dim3(grid), dim3(NTHR), LDS_BYTES, stream, a); }
#endif
}
```
